# Optimizing an MI355X kernel written in HIP

```python
import math
import jax, jax.numpy as jnp
from jax import lax
import numpy as np

D_MODEL = 1024
BATCH = 8
SEQ = 2048
DEPTH = 4

D_RNN = D_MODEL
N_LRU_BLOCKS = 8
LRU_BLOCK = D_RNN // N_LRU_BLOCKS
RNN_CONV_WIDTH = 4
LRU_C = 8.0
HEAD_DIM = 128
HEADS_PER_GROUP = 4
DILATED_GROUPS = ((128, 1), (512, 4), (2048, 16))
N_GROUPS = len(DILATED_GROUPS)
N_ATT_HEADS = N_GROUPS * HEADS_PER_GROUP
ATT_WIDTH = N_ATT_HEADS * HEAD_DIM
ATT_OUT_WIDTH = HEADS_PER_GROUP * HEAD_DIM
BLOCK = 128
ROPE_THETA = 10000.0
D_FF = 3 * D_MODEL
FFN_CONV_WIDTH = 3
EPS = 1e-6
NEG_INF = -1e30
IN_SPLITS = (D_RNN, D_RNN, ATT_WIDTH, ATT_WIDTH, ATT_WIDTH, D_MODEL, D_MODEL)
N_IN = sum(IN_SPLITS)

kernel_name = "hybrid_rglru_dilated_attn_convffn"


def rms_norm(x, g):
    x32 = x.astype(jnp.float32)
    y = x32 * lax.rsqrt(jnp.mean(x32 * x32, axis=-1, keepdims=True) + EPS)
    return (y * g.astype(jnp.float32)).astype(x.dtype)


def causal_depthwise_conv(x, w, b):
    width = w.shape[0]
    s = x.shape[1]
    xp = jnp.pad(x, ((0, 0), (width - 1, 0), (0, 0)))
    out = b
    for i in range(width):
        out = out + xp[:, i:i + s] * w[i]
    return out


def block_diag_linear(x, w, b):
    bsz, s, c = x.shape
    nb = w.shape[0]
    y = jnp.einsum('bsni,nij->bsnj', x.reshape(bsz, s, nb, c // nb), w)
    return y.reshape(bsz, s, c) + b


def rg_lru(x, wa, ba, wx, bx, lam):
    r = jax.nn.sigmoid(block_diag_linear(x, wa, ba).astype(jnp.float32))
    i = jax.nn.sigmoid(block_diag_linear(x, wx, bx).astype(jnp.float32))
    log_a = -LRU_C * r * jax.nn.softplus(-lam.astype(jnp.float32))
    a = jnp.exp(log_a)
    mult = jnp.sqrt(-jnp.expm1(2.0 * log_a))
    u = mult * (i * x.astype(jnp.float32))

    def combine(left, right):
        a_l, b_l = left
        a_r, b_r = right
        return a_l * a_r, a_r * b_l + b_r

    _, h = lax.associative_scan(combine, (a, u), axis=1)
    return h.astype(x.dtype)


def rotary(x, positions):
    half = x.shape[-1] // 2
    inv_freq = ROPE_THETA ** (-jnp.arange(half, dtype=jnp.float32) / half)
    ang = positions.astype(jnp.float32)[..., None] * inv_freq
    cos = jnp.cos(ang)[:, :, None, :]
    sin = jnp.sin(ang)[:, :, None, :]
    x32 = x.astype(jnp.float32)
    x1, x2 = x32[..., :half], x32[..., half:]
    return jnp.concatenate([x1 * cos - x2 * sin, x2 * cos + x1 * sin], axis=-1).astype(x.dtype)


def dilated_window_attention(q, k, v, dilation, span):
    bsz, s, h, dh = q.shape
    n = s // dilation
    nb = -(-n // BLOCK)
    n_pad = nb * BLOCK

    def to_blocks(t):
        t = t.reshape(bsz, n, dilation, h, dh).transpose(0, 2, 1, 3, 4)
        t = jnp.pad(t, ((0, 0), (0, 0), (0, n_pad - n), (0, 0), (0, 0)))
        return t.reshape(bsz, dilation, nb, BLOCK, h, dh)

    def with_prev(t):
        prev = jnp.pad(t, ((0, 0), (0, 0), (1, 0), (0, 0), (0, 0), (0, 0)))[:, :, :-1]
        return jnp.concatenate([prev, t], axis=3)

    qb = to_blocks(q)
    kw = with_prev(to_blocks(k))
    vw = with_prev(to_blocks(v))
    scores = jnp.einsum('bgnqhd,bgnkhd->bgnhqk', qb, kw).astype(jnp.float32)
    qi = jnp.arange(BLOCK)[:, None]
    kj = jnp.arange(2 * BLOCK)[None, :]
    dist = qi + BLOCK - kj
    blk = jnp.arange(nb)[:, None, None]
    valid = (dist >= 0)[None] & (dist <= span)[None] & ((blk > 0) | (kj >= BLOCK)[None])
    scores = jnp.where(valid[None, None, :, None], scores, NEG_INF)
    m = jnp.max(scores, axis=-1, keepdims=True)
    p = jnp.exp(scores - m)
    den = jnp.sum(p, axis=-1, keepdims=True)
    out = jnp.einsum('bgnhqk,bgnkhd->bgnqhd', (p / den).astype(v.dtype), vw)
    lse = (m + jnp.log(den))[..., 0].transpose(0, 1, 2, 4, 3)
    out = out.reshape(bsz, dilation, n_pad, h, dh)[:, :, :n].transpose(0, 2, 1, 3, 4).reshape(bsz, s, h, dh)
    lse = lse.reshape(bsz, dilation, n_pad, h)[:, :, :n].transpose(0, 2, 1, 3).reshape(bsz, s, h)
    return out, lse


def dilated_attention_mixer(q, k, v, positions, q_g, k_g):
    bsz, s, _ = q.shape
    q = q.reshape(bsz, s, N_ATT_HEADS, HEAD_DIM)
    k = k.reshape(bsz, s, N_ATT_HEADS, HEAD_DIM)
    v = v.reshape(bsz, s, N_ATT_HEADS, HEAD_DIM)
    q = rotary(rms_norm(q, q_g), positions) * (HEAD_DIM ** -0.5)
    k = rotary(rms_norm(k, k_g), positions)
    outs, lses = [], []
    for gi, (window, dilation) in enumerate(DILATED_GROUPS):
        hs = slice(gi * HEADS_PER_GROUP, (gi + 1) * HEADS_PER_GROUP)
        o, l = dilated_window_attention(q[:, :, hs], k[:, :, hs], v[:, :, hs], dilation, window // dilation)
        outs.append(o)
        lses.append(l)
    wts = jax.nn.softmax(jnp.stack(lses, axis=0), axis=0)
    o = jnp.sum(wts[..., None] * jnp.stack(outs, axis=0).astype(jnp.float32), axis=0)
    return o.reshape(bsz, s, ATT_OUT_WIDTH).astype(q.dtype)


def setup_inputs(seed: int = 0) -> dict:
    key = jax.random.key(seed)
    ks = jax.random.split(key, 24)
    f32 = jnp.float32

    def nrm(k, shape, scale):
        return jax.random.normal(k, shape, f32) * scale

    x = jax.random.normal(ks[0], (BATCH, SEQ, D_MODEL), f32)
    offsets = jax.random.randint(ks[1], (BATCH, 1), 0, 1024, dtype=jnp.int32)
    positions = offsets + jnp.arange(SEQ, dtype=jnp.int32)[None, :]
    a_pow = jax.random.uniform(ks[2], (DEPTH, D_RNN), f32, 0.9, 0.999)
    a0 = a_pow ** (1.0 / LRU_C)
    lru_lambda = jnp.log(a0) - jnp.log1p(-a0)
    return {
        "x": x,
        "positions": positions,
        "ln1_g": 1.0 + nrm(ks[3], (DEPTH, D_MODEL), 0.02),
        "w_in": nrm(ks[4], (DEPTH, D_MODEL, N_IN), D_MODEL ** -0.5),
        "rnn_conv_w": nrm(ks[5], (DEPTH, RNN_CONV_WIDTH, D_RNN), RNN_CONV_WIDTH ** -0.5),
        "rnn_conv_b": nrm(ks[6], (DEPTH, D_RNN), 0.01),
        "lru_wa": nrm(ks[7], (DEPTH, N_LRU_BLOCKS, LRU_BLOCK, LRU_BLOCK), LRU_BLOCK ** -0.5),
        "lru_ba": nrm(ks[8], (DEPTH, D_RNN), 0.01),
        "lru_wx": nrm(ks[9], (DEPTH, N_LRU_BLOCKS, LRU_BLOCK, LRU_BLOCK), LRU_BLOCK ** -0.5),
        "lru_bx": nrm(ks[10], (DEPTH, D_RNN), 0.01),
        "lru_lambda": lru_lambda,
        "q_norm_g": 1.0 + nrm(ks[11], (DEPTH, N_ATT_HEADS, HEAD_DIM), 0.02),
        "k_norm_g": 1.0 + nrm(ks[12], (DEPTH, N_ATT_HEADS, HEAD_DIM), 0.02),
        "proj_rnn": nrm(ks[13], (DEPTH, D_RNN, D_MODEL), D_RNN ** -0.5),
        "proj_attn": nrm(ks[14], (DEPTH, ATT_OUT_WIDTH, D_MODEL), ATT_OUT_WIDTH ** -0.5),
        "w_out": nrm(ks[15], (DEPTH, D_MODEL, D_MODEL), D_MODEL ** -0.5),
        "ln2_g": 1.0 + nrm(ks[16], (DEPTH, D_MODEL), 0.02),
        "w_up": nrm(ks[17], (DEPTH, D_MODEL, 2 * D_FF), D_MODEL ** -0.5),
        "ffn_conv_w": nrm(ks[18], (DEPTH, FFN_CONV_WIDTH, 2 * D_FF), FFN_CONV_WIDTH ** -0.5),
        "ffn_conv_b": nrm(ks[19], (DEPTH, 2 * D_FF), 0.01),
        "w_down": nrm(ks[20], (DEPTH, D_FF, D_MODEL), D_FF ** -0.5),
    }


def reference(x, positions, ln1_g, w_in, rnn_conv_w, rnn_conv_b, lru_wa, lru_ba, lru_wx, lru_bx,
              lru_lambda, q_norm_g, k_norm_g, proj_rnn, proj_attn, w_out, ln2_g, w_up,
              ffn_conv_w, ffn_conv_b, w_down):
    cuts = np.cumsum(IN_SPLITS)[:-1].tolist()
    for l in range(DEPTH):
        h = rms_norm(x, ln1_g[l])
        z = h @ w_in[l]
        xr, gr, q, k, v, g_rnn, g_att = jnp.split(z, cuts, axis=-1)
        xr = causal_depthwise_conv(xr, rnn_conv_w[l], rnn_conv_b[l])
        hr = rg_lru(xr, lru_wa[l], lru_ba[l], lru_wx[l], lru_bx[l], lru_lambda[l])
        y_rnn = hr * jax.nn.gelu(gr)
        y_att = dilated_attention_mixer(q, k, v, positions, q_norm_g[l], k_norm_g[l])
        merged = jax.nn.sigmoid(g_rnn) * (y_rnn @ proj_rnn[l]) + jax.nn.sigmoid(g_att) * (y_att @ proj_attn[l])
        x = x + merged @ w_out[l]
        h2 = rms_norm(x, ln2_g[l])
        u = causal_depthwise_conv(h2 @ w_up[l], ffn_conv_w[l], ffn_conv_b[l])
        u_gate, u_val = jnp.split(u, 2, axis=-1)
        x = x + (jax.nn.gelu(u_gate) * u_val) @ w_down[l]
    return x
```

```cpp
#include <hip/hip_runtime.h>
#include <hip/hip_cooperative_groups.h>
#include <cstdio>
namespace cg = cooperative_groups;

#ifndef MK_MULTI
#define MK_MULTI 1
#endif
#ifndef PHASE_MASK
#define PHASE_MASK 0x1ff
#endif
#ifndef DBG_NPH
#define DBG_NPH 33
#endif
#ifndef USE_CG_SYNC
#define USE_CG_SYNC 0
#endif

#define DI __device__ __forceinline__
#define LAS __attribute__((address_space(3)))
typedef unsigned short bf16_t;
typedef short bf16x8 __attribute__((ext_vector_type(8)));
typedef float f32x2 __attribute__((ext_vector_type(2)));
typedef float f32x4 __attribute__((ext_vector_type(4)));
typedef float f32x16 __attribute__((ext_vector_type(16)));
typedef unsigned u32x2 __attribute__((ext_vector_type(2)));
typedef unsigned u32x4 __attribute__((ext_vector_type(4)));
typedef __bf16 bf16x2v __attribute__((ext_vector_type(2)));

constexpr int T = 16384, SEQ = 2048, NBATCH = 8, DEPTH = 4;
constexpr int DM = 1024, NIN = 8704, AW = 1536, DFF = 3072, NUP = 6144;
constexpr float EPS = 1e-6f;

constexpr size_t MiB = 1u << 20;
constexpr size_t WS_CTL = 0, CTL_BYTES = 1 * MiB;
constexpr size_t WS_SSP = 1 * MiB;
constexpr size_t WS_AGGA = 2 * MiB, WS_AGGH = 3 * MiB;
constexpr size_t WS_LSE = 4 * MiB;
constexpr size_t WS_COS = 5 * MiB, WS_SIN = 9 * MiB;
constexpr size_t WS_W1T = 13 * MiB;
constexpr size_t WS_WUT = 30 * MiB;
constexpr size_t WS_WDT = 42 * MiB;
constexpr size_t WS_PRT = 48 * MiB;
constexpr size_t WS_PAT = 50 * MiB;
constexpr size_t WS_WOT = 51 * MiB;
constexpr size_t WS_WAT = 53 * MiB;
constexpr size_t WS_WXT = 53 * MiB + 262144;
constexpr size_t WS_XB = 54 * MiB;
constexpr size_t WS_AR = 86 * MiB;
constexpr size_t AR_XR = 0, AR_YR = 0;
constexpr size_t AR_GG = 32 * MiB, AR_MG = 32 * MiB;
constexpr size_t AR_SGR = 64 * MiB, AR_SGA = 96 * MiB;
constexpr size_t AR_Q = 128 * MiB, AR_K = 176 * MiB, AR_V = 224 * MiB;
constexpr size_t AR_YA = 128 * MiB, AR_TMP = 144 * MiB;
constexpr size_t AR_HL = 272 * MiB, AR_OG = 336 * MiB;
constexpr size_t AR_U = 0, AR_ACT = 192 * MiB;
constexpr size_t WS_END = WS_AR + 384 * MiB;

constexpr int RING_BYTES = 131072;
constexpr int TAB_OFF = RING_BYTES;
constexpr int MISC_OFF = RING_BYTES + 8192;
constexpr int LDS_BYTES = 147456;

#define LDS_WAIT() asm volatile("s_waitcnt lgkmcnt(0)" ::: "memory")
DI unsigned f2bf(float f) { unsigned u = __builtin_bit_cast(unsigned, f); return (u + 0x7fffu + ((u >> 16) & 1u)) >> 16; }
DI unsigned pk2(float lo, float hi) { f32x2 v = {lo, hi}; return __builtin_bit_cast(unsigned, __builtin_convertvector(v, bf16x2v)); }
DI float bflo(unsigned w) { return __builtin_bit_cast(float, w << 16); }
DI float bfhi(unsigned w) { return __builtin_bit_cast(float, w & 0xffff0000u); }
DI float sigmoidf_(float x) { return 1.0f / (1.0f + __expf(-x)); }
DI float gelu_tanh(float x) { const float y = 1.5957691216057308f * (x + 0.044715f * x * x * x); return x / (1.0f + __expf(-y)); }
DI unsigned pkh2(float lo, float hi) { const _Float16 a = (_Float16)lo, b = (_Float16)hi; return (unsigned)__builtin_bit_cast(unsigned short, a) | ((unsigned)__builtin_bit_cast(unsigned short, b) << 16); }
DI float hlo(unsigned w) { return (float)__builtin_bit_cast(_Float16, (unsigned short)(w & 0xffffu)); }
DI float hhi(unsigned w) { return (float)__builtin_bit_cast(_Float16, (unsigned short)(w >> 16)); }

namespace pg8 {
constexpr int BM = 256, BK = 64, HALF = 128, HTB = HALF * BK * 2, NXCD = 8, WGM = 8;
DI int lds_byte(int r, int c) { const int st = (r >> 4) * 2 + (c >> 5), rr = r & 15, cc = c & 31, ob = rr * 64 + cc * 2; return st * 1024 + (ob ^ (((ob >> 9) & 1) << 5)); }
DI void stage_rc(int b, int& R, int& C) { const int st = b / 1024, sb = b % 1024, swz = sb ^ (((sb >> 9) & 1) << 5); R = (st >> 1) * 16 + swz / 64; C = (st & 1) * 32 + (swz % 64) / 2; }
DI int perm32(int rho) { const int n = rho >> 4, i = rho & 15; return 8 * (i >> 2) + 4 * n + (i & 3); }
struct Unit { int pm, pn; };
struct Gemm { const bf16_t* A; const bf16_t* Bt; int M, N, K; };
struct StaticOrder {
    int nM, nN, nwg, G, c;
    DI void init(int M, int N, int G_, int c_) { nM = M / BM; nN = N / BM; nwg = nM * nN; G = G_; c = c_; }
    DI bool next(int i, Unit& u) const {
        const long L = (long)i * G + c; if (L >= nwg) return false;
        int wgid = (int)L; { const int q = nwg / NXCD, r = nwg % NXCD, xcd = wgid % NXCD, off = wgid / NXCD; wgid = (xcd < r ? xcd * (q + 1) : r * (q + 1) + (xcd - r) * q) + off; }
        const int nig = WGM * nN, gid = wgid / nig, fm = gid * WGM, gsz = (nM - fm) < WGM ? (nM - fm) : WGM;
        u.pm = fm + ((wgid % nig) % gsz); u.pn = (wgid % nig) / gsz; return true;
    }
};
DI unsigned cvt_pk_bf16(float lo, float hi) { unsigned r; asm volatile("v_cvt_pk_bf16_f32 %0, %1, %2" : "=v"(r) : "v"(lo), "v"(hi)); return r; }

template <class Epi>
DI void gemm_phase(LAS unsigned char* lds, const Gemm g, const StaticOrder& S, const Epi& E) {
    int tid = threadIdx.x; asm volatile("" : "+v"(tid));
    const int wid = __builtin_amdgcn_readfirstlane(tid >> 6), lane = tid & 63, wr = wid >> 2, wc = wid & 3, fr = lane & 15, fq = lane >> 4;
    const int K = g.K, nt = K / BK;
    unsigned voffA[2], voffB[2];
#pragma unroll
    for (int i = 0; i < 2; ++i) { int R, C; stage_rc(tid * 16 + i * 8192, R, C); const int Rb = (R & ~31) + perm32(R & 31);
        voffA[i] = (unsigned)(R * K + C) * 2u; voffB[i] = (unsigned)(Rb * K + C) * 2u; }
    const size_t kstep = (size_t)(BK * 2);
    const size_t hstep = (size_t)HALF * K * 2;
    const size_t tstep = 2 * hstep;
    const unsigned ldsw = (unsigned)wid * 1024u;
    const int aoff = lds_byte(wr * 64 + fr, fq * 8), boff = lds_byte(wc * 32 + fr, fq * 8);
#define PG8_SA(b, h) (((b) * 2 + (h)) * HTB)
#define PG8_SB(b, h) ((4 + (b) * 2 + (h)) * HTB)
#define PG8_STAGE(bufoff, gbase, voff) do { _Pragma("unroll") for (int _i = 0; _i < 2; ++_i) \
        __builtin_amdgcn_global_load_lds((const unsigned*)((const char*)(gbase) + (voff)[_i]), (LAS unsigned*)(lds + (bufoff) + ldsw + _i * 8192), 16, 0, 0); } while (0)
#define PG8_LDA(dst, b, h) do { _Pragma("unroll") for (int m = 0; m < 4; ++m) _Pragma("unroll") for (int k = 0; k < 2; ++k) dst[m][k] = *(const LAS bf16x8*)(lds + PG8_SA(b, h) + aoff + m * 2048 + k * 1024); } while (0)
#define PG8_LDB(dst, b, h) do { _Pragma("unroll") for (int n = 0; n < 2; ++n) _Pragma("unroll") for (int k = 0; k < 2; ++k) dst[n][k] = *(const LAS bf16x8*)(lds + PG8_SB(b, h) + boff + n * 2048 + k * 1024); } while (0)
#define PG8_MMA(ai, bj, At, Bt) do { __builtin_amdgcn_s_setprio(1); _Pragma("unroll") for (int m = 0; m < 4; ++m) _Pragma("unroll") for (int n = 0; n < 2; ++n) _Pragma("unroll") for (int k = 0; k < 2; ++k) \
        acc[ai][bj][m][n] = __builtin_amdgcn_mfma_f32_16x16x32_bf16(Bt[n][k], At[m][k], acc[ai][bj][m][n], 0, 0, 0); __builtin_amdgcn_s_setprio(0); } while (0)
#define PG8_WAIT_V(n) asm volatile("s_waitcnt vmcnt(" #n ")" ::: "memory")
#define PG8_WAIT_L(n) asm volatile("s_waitcnt lgkmcnt(" #n ")" ::: "memory")
#define PG8_BAR __builtin_amdgcn_s_barrier()
#define PG8_SCHED __builtin_amdgcn_sched_barrier(0)
    Unit cur, nxt; int ui = 0;
    if (!S.next(0, cur)) return;
    f32x4 acc[2][2][4][2];
#pragma unroll
    for (int a = 0; a < 2; ++a)
#pragma unroll
        for (int b = 0; b < 2; ++b)
#pragma unroll
            for (int m = 0; m < 4; ++m)
#pragma unroll
                for (int n = 0; n < 2; ++n) acc[a][b][m][n] = (f32x4){0.f, 0.f, 0.f, 0.f};
    bf16x8 At[4][2], B0[2][2], B1[2][2];
    const char* cA = (const char*)g.A + (size_t)cur.pm * tstep; const char* cB = (const char*)g.Bt + (size_t)cur.pn * tstep;
    PG8_STAGE(PG8_SB(0, 0), cB, voffB); PG8_STAGE(PG8_SA(0, 0), cA, voffA); PG8_STAGE(PG8_SB(0, 1), cB + hstep, voffB); PG8_STAGE(PG8_SA(0, 1), cA + hstep, voffA);
    if (wr == 1) PG8_BAR;
    PG8_WAIT_V(4); PG8_BAR;
    PG8_STAGE(PG8_SB(1, 0), cB + kstep, voffB); PG8_STAGE(PG8_SA(1, 0), cA + kstep, voffA); PG8_STAGE(PG8_SB(1, 1), cB + hstep + kstep, voffB);
    PG8_WAIT_V(6); PG8_BAR;
    for (;;) {
        const bool has_next = S.next(ui + 1, nxt);
        const char* nA = has_next ? (const char*)g.A + (size_t)nxt.pm * tstep : cA; const char* nB = has_next ? (const char*)g.Bt + (size_t)nxt.pn * tstep : cB;
        for (int t = 0; t < nt; t += 2) {
            const bool last = (t == nt - 2);
            const char* a1 = cA + (size_t)(t + 1) * kstep;
            const char* a2 = last ? nA : cA + (size_t)(t + 2) * kstep; const char* b2 = last ? nB : cB + (size_t)(t + 2) * kstep;
            const char* a3 = a2 + kstep; const char* b3 = b2 + kstep;
            PG8_LDB(B0, 0, 0); PG8_SCHED; PG8_LDA(At, 0, 0); PG8_STAGE(PG8_SA(1, 1), a1 + hstep, voffA);
            PG8_WAIT_L(8); PG8_BAR; PG8_WAIT_L(0); PG8_MMA(0, 0, At, B0); PG8_BAR; PG8_SCHED;
            PG8_LDB(B1, 0, 1); PG8_STAGE(PG8_SB(0, 0), b2, voffB);
            PG8_BAR; PG8_WAIT_L(0); PG8_MMA(0, 1, At, B1); PG8_BAR;
            PG8_LDA(At, 0, 1); PG8_STAGE(PG8_SA(0, 0), a2, voffA);
            PG8_BAR; PG8_WAIT_L(0); PG8_MMA(1, 0, At, B0); PG8_BAR; PG8_SCHED;
            PG8_STAGE(PG8_SB(0, 1), b2 + hstep, voffB);
            PG8_WAIT_V(6); PG8_BAR; PG8_MMA(1, 1, At, B1); PG8_BAR;
            PG8_LDB(B0, 1, 0); PG8_SCHED; PG8_LDA(At, 1, 0); PG8_STAGE(PG8_SA(0, 1), a2 + hstep, voffA);
            PG8_WAIT_L(8); PG8_BAR; PG8_WAIT_L(0); PG8_MMA(0, 0, At, B0); PG8_BAR; PG8_SCHED;
            PG8_LDB(B1, 1, 1); PG8_STAGE(PG8_SB(1, 0), b3, voffB);
            PG8_BAR; PG8_WAIT_L(0); PG8_MMA(0, 1, At, B1); PG8_BAR;
            PG8_LDA(At, 1, 1); PG8_STAGE(PG8_SA(1, 0), a3, voffA);
            PG8_BAR; PG8_WAIT_L(0); PG8_MMA(1, 0, At, B0); PG8_BAR; PG8_SCHED;
            PG8_STAGE(PG8_SB(1, 1), b3 + hstep, voffB);
            PG8_WAIT_V(6); PG8_BAR; PG8_MMA(1, 1, At, B1); PG8_BAR;
        }
        E(acc, cur, wr, wc, fr, fq);
        if (!has_next) break;
#pragma unroll
        for (int a = 0; a < 2; ++a)
#pragma unroll
            for (int b = 0; b < 2; ++b)
#pragma unroll
                for (int m = 0; m < 4; ++m)
#pragma unroll
                    for (int n = 0; n < 2; ++n) acc[a][b][m][n] = (f32x4){0.f, 0.f, 0.f, 0.f};
        cur = nxt; cA = nA; cB = nB; ++ui;
    }
    PG8_WAIT_V(0);
    if (wr == 0) PG8_BAR;
    PG8_BAR;
#undef PG8_SA
#undef PG8_SB
#undef PG8_STAGE
#undef PG8_LDA
#undef PG8_LDB
#undef PG8_MMA
#undef PG8_WAIT_V
#undef PG8_WAIT_L
#undef PG8_BAR
#undef PG8_SCHED
}

typedef f32x4 Acc[2][2][4][2];

DI void row_scales(const float* ssp, int row0, int fq, float (&rs)[2][4]) {
#pragma unroll
    for (int ai = 0; ai < 2; ++ai)
#pragma unroll
        for (int m = 0; m < 4; ++m) {
            const f32x4 p = *(const f32x4*)(ssp + (size_t)(row0 + ai * HALF + m * 16) * 16 + 4 * fq);
            float s = (p.x + p.y) + (p.z + p.w); s += __shfl_xor(s, 16); s += __shfl_xor(s, 32);
            rs[ai][m] = rsqrtf(s * (1.0f / 1024.0f) + EPS);
        }
}

DI float row_scale1(const float* ssp, int row, int fq) {
    const f32x4 p = *(const f32x4*)(ssp + (size_t)row * 16 + 4 * fq);
    float s = (p.x + p.y) + (p.z + p.w); s += __shfl_xor(s, 16); s += __shfl_xor(s, 32);
    return rsqrtf(s * (1.0f / 1024.0f) + EPS);
}
template <int ACT> DI void store_plain(Acc& acc, const float* ssp, bf16_t* O, int ldc, int row0, int col0, int fq) {
#pragma unroll
    for (int ai = 0; ai < 2; ++ai)
#pragma unroll
        for (int m = 0; m < 4; ++m) { int r0v = row0; asm volatile("" : "+v"(r0v)); const int row = r0v + ai * HALF + m * 16; bf16_t* rowp = O + (size_t)row * ldc + col0; const float s = row_scale1(ssp, row, fq);
#pragma unroll
            for (int bj = 0; bj < 2; ++bj) { f32x4 v0 = acc[ai][bj][m][0] * s, v1 = acc[ai][bj][m][1] * s;
                if (ACT == 1) {
#pragma unroll
                    for (int j = 0; j < 4; ++j) { v0[j] = gelu_tanh(v0[j]); v1[j] = gelu_tanh(v1[j]); } }
                if (ACT == 2) {
#pragma unroll
                    for (int j = 0; j < 4; ++j) { v0[j] = sigmoidf_(v0[j]); v1[j] = sigmoidf_(v1[j]); } }
                u32x4 w; w.x = cvt_pk_bf16(v0[0], v0[1]); w.y = cvt_pk_bf16(v0[2], v0[3]); w.z = cvt_pk_bf16(v1[0], v1[1]); w.w = cvt_pk_bf16(v1[2], v1[3]);
                *(u32x4*)(rowp + bj * HALF) = w; }
            asm volatile("" ::: "memory"); }
}
struct EpiIn {
    const float* ssp; bf16_t *XR, *GG, *SGR, *SGA, *Q, *Kc, *V; const float *qg, *kg, *cosT, *sinT; LAS float* tab;
    DI void operator()(Acc& acc, const Unit& u, int wr, int wc, int fr, int fq) const {
        const int row0 = u.pm * BM + wr * 64 + fr, pn = u.pn;
        if (pn < 16 || pn >= 28) {
            const int cw = wc * 32 + 8 * fq;
            if (pn < 4) store_plain<0>(acc, ssp, XR, 1024, row0, pn * 256 + cw, fq);
            else if (pn < 8) store_plain<1>(acc, ssp, GG, 1024, row0, (pn - 4) * 256 + cw, fq);
            else if (pn < 12) store_plain<2>(acc, ssp, SGR, 1024, row0, (pn - 8) * 256 + cw, fq);
            else if (pn < 16) store_plain<2>(acc, ssp, SGA, 1024, row0, (pn - 12) * 256 + cw, fq);
            else store_plain<0>(acc, ssp, V, 1536, row0, (pn - 28) * 256 + cw, fq);
        } else {
            const bool isq = pn < 22; const int head0 = 2 * (pn - (isq ? 16 : 22)); bf16_t* O = isq ? Q : Kc; const float* gw = isq ? qg : kg; const float osc = isq ? 0.08838834764831845f : 1.0f;
            const int d0 = 16 * wc + 4 * fq;
#pragma unroll
            for (int ai = 0; ai < 2; ++ai)
#pragma unroll
                for (int m = 0; m < 4; ++m) { int r0v = row0; asm volatile("" : "+v"(r0v)); const float s = row_scale1(ssp, r0v + ai * HALF + m * 16, fq); const int rl = (r0v & 255) + ai * HALF + m * 16;
#pragma unroll
                    for (int bj = 0; bj < 2; ++bj) { const f32x4 a = acc[ai][bj][m][0], b = acc[ai][bj][m][1];
                        float q = (a[0] * a[0] + a[1] * a[1]) + (a[2] * a[2] + a[3] * a[3]) + (b[0] * b[0] + b[1] * b[1]) + (b[2] * b[2] + b[3] * b[3]);
                        q *= s * s; q += __shfl_xor(q, 16); q += __shfl_xor(q, 32);
                        if (fq == 0) tab[(rl * 2 + bj) * 4 + wc] = q; }
                    asm volatile("" ::: "memory"); }
            asm volatile("s_waitcnt lgkmcnt(0)" ::: "memory"); __builtin_amdgcn_s_barrier(); asm volatile("" ::: "memory");
            const f32x4 g1a = *(const f32x4*)(gw + head0 * 128 + d0), g2a = *(const f32x4*)(gw + head0 * 128 + 64 + d0);
            const f32x4 g1b = *(const f32x4*)(gw + head0 * 128 + 128 + d0), g2b = *(const f32x4*)(gw + head0 * 128 + 192 + d0);
#pragma unroll
            for (int ai = 0; ai < 2; ++ai)
#pragma unroll
                for (int m = 0; m < 4; ++m) { int r0v = row0; asm volatile("" : "+v"(r0v)); const int rl = (r0v & 255) + ai * HALF + m * 16; const size_t row = (size_t)(r0v + ai * HALF + m * 16);
                    const f32x4 cs = *(const f32x4*)(cosT + row * 64 + d0), sn = *(const f32x4*)(sinT + row * 64 + d0); const float s = row_scale1(ssp, (int)row, fq) * osc;
#pragma unroll
                    for (int bj = 0; bj < 2; ++bj) { const f32x4 pp = *(const LAS f32x4*)(tab + (rl * 2 + bj) * 4);
                        const float inv = rsqrtf(((pp.x + pp.y) + (pp.z + pp.w)) * (1.0f / 128.0f) + EPS) * s;
                        const f32x4 x1 = acc[ai][bj][m][0] * inv * (bj ? g1b : g1a), x2 = acc[ai][bj][m][1] * inv * (bj ? g2b : g2a);
                        const f32x4 o1 = x1 * cs - x2 * sn, o2 = x2 * cs + x1 * sn;
                        u32x2 w1, w2; w1.x = cvt_pk_bf16(o1[0], o1[1]); w1.y = cvt_pk_bf16(o1[2], o1[3]); w2.x = cvt_pk_bf16(o2[0], o2[1]); w2.y = cvt_pk_bf16(o2[2], o2[3]);
                        bf16_t* p = O + row * AW + (head0 + bj) * 128 + d0; *(u32x2*)p = w1; *(u32x2*)(p + 64) = w2; }
                    asm volatile("" ::: "memory"); }
        }
    }
};
struct EpiProj1 {
    const bf16_t* SG; float* TMP;
    DI void operator()(Acc& acc, const Unit& u, int wr, int wc, int fr, int fq) const {
        const int row0 = u.pm * BM + wr * 64 + fr, col0 = u.pn * BM + wc * 32 + 8 * fq;
#pragma unroll
        for (int ai = 0; ai < 2; ++ai)
#pragma unroll
            for (int m = 0; m < 4; ++m) { int r0v = row0; asm volatile("" : "+v"(r0v)); const size_t off = (size_t)(r0v + ai * HALF + m * 16) * DM + col0;
#pragma unroll
                for (int bj = 0; bj < 2; ++bj) { const u32x4 sg = *(const u32x4*)(SG + off + bj * HALF);
                    f32x4 v0 = acc[ai][bj][m][0], v1 = acc[ai][bj][m][1];
                    v0[0] *= bflo(sg.x); v0[1] *= bfhi(sg.x); v0[2] *= bflo(sg.y); v0[3] *= bfhi(sg.y); v1[0] *= bflo(sg.z); v1[1] *= bfhi(sg.z); v1[2] *= bflo(sg.w); v1[3] *= bfhi(sg.w);
                    *(f32x4*)(TMP + off + bj * HALF) = v0; *(f32x4*)(TMP + off + bj * HALF + 4) = v1; }
                asm volatile("" ::: "memory"); }
    }
};
struct EpiProj2 {
    const bf16_t* SG; const float* TMP; bf16_t* MG;
    DI void operator()(Acc& acc, const Unit& u, int wr, int wc, int fr, int fq) const {
        const int row0 = u.pm * BM + wr * 64 + fr, col0 = u.pn * BM + wc * 32 + 8 * fq;
#pragma unroll
        for (int ai = 0; ai < 2; ++ai)
#pragma unroll
            for (int m = 0; m < 4; ++m) { int r0v = row0; asm volatile("" : "+v"(r0v)); const size_t off = (size_t)(r0v + ai * HALF + m * 16) * DM + col0;
#pragma unroll
                for (int bj = 0; bj < 2; ++bj) { const u32x4 sg = *(const u32x4*)(SG + off + bj * HALF);
                    const f32x4 t0 = *(const f32x4*)(TMP + off + bj * HALF), t1 = *(const f32x4*)(TMP + off + bj * HALF + 4);
                    f32x4 v0 = acc[ai][bj][m][0], v1 = acc[ai][bj][m][1];
                    v0[0] = t0[0] + v0[0] * bflo(sg.x); v0[1] = t0[1] + v0[1] * bfhi(sg.x); v0[2] = t0[2] + v0[2] * bflo(sg.y); v0[3] = t0[3] + v0[3] * bfhi(sg.y);
                    v1[0] = t1[0] + v1[0] * bflo(sg.z); v1[1] = t1[1] + v1[1] * bfhi(sg.z); v1[2] = t1[2] + v1[2] * bflo(sg.w); v1[3] = t1[3] + v1[3] * bfhi(sg.w);
                    u32x4 w; w.x = cvt_pk_bf16(v0[0], v0[1]); w.y = cvt_pk_bf16(v0[2], v0[3]); w.z = cvt_pk_bf16(v1[0], v1[1]); w.w = cvt_pk_bf16(v1[2], v1[3]);
                    *(u32x4*)(MG + off + bj * HALF) = w; }
                asm volatile("" ::: "memory"); }
    }
};
struct EpiResid {
    const float* xin; float* xout; bf16_t* XB; float* ssp;
    DI void operator()(Acc& acc, const Unit& u, int wr, int wc, int fr, int fq) const {
        const int row0 = u.pm * BM + wr * 64 + fr, col0 = u.pn * BM + wc * 32 + 8 * fq;
#pragma unroll
        for (int ai = 0; ai < 2; ++ai)
#pragma unroll
            for (int m = 0; m < 4; ++m) { int r0v = row0; asm volatile("" : "+v"(r0v)); const int row = r0v + ai * HALF + m * 16; const size_t off = (size_t)row * DM + col0; float q = 0.f;
#pragma unroll
                for (int bj = 0; bj < 2; ++bj) {
                    const f32x4 a0 = *(const f32x4*)(xin + off + bj * HALF), a1 = *(const f32x4*)(xin + off + bj * HALF + 4);
                    const f32x4 o0 = a0 + acc[ai][bj][m][0], o1 = a1 + acc[ai][bj][m][1];
                    *(f32x4*)(xout + off + bj * HALF) = o0; *(f32x4*)(xout + off + bj * HALF + 4) = o1;
                    q += (o0[0] * o0[0] + o0[1] * o0[1]) + (o0[2] * o0[2] + o0[3] * o0[3]) + (o1[0] * o1[0] + o1[1] * o1[1]) + (o1[2] * o1[2] + o1[3] * o1[3]);
                    u32x4 w; w.x = cvt_pk_bf16(o0[0], o0[1]); w.y = cvt_pk_bf16(o0[2], o0[3]); w.z = cvt_pk_bf16(o1[0], o1[1]); w.w = cvt_pk_bf16(o1[2], o1[3]);
                    *(u32x4*)(XB + off + bj * HALF) = w; }
                q += __shfl_xor(q, 16); q += __shfl_xor(q, 32);
                if (fq == 0) ssp[(size_t)row * 16 + u.pn * 4 + wc] = q;
                asm volatile("" ::: "memory"); }
    }
};
struct EpiUp {
    const float* ssp; bf16_t* U;
    DI void operator()(Acc& acc, const Unit& u, int wr, int wc, int fr, int fq) const {
        const int row0 = u.pm * BM + wr * 64 + fr, col0 = u.pn * BM + wc * 32 + 8 * fq;
#pragma unroll
        for (int ai = 0; ai < 2; ++ai)
#pragma unroll
            for (int m = 0; m < 4; ++m) { int r0v = row0; asm volatile("" : "+v"(r0v)); const int row = r0v + ai * HALF + m * 16; bf16_t* rowp = U + (size_t)row * NUP + col0; const float s = row_scale1(ssp, row, fq);
#pragma unroll
                for (int bj = 0; bj < 2; ++bj) { const f32x4 v0 = acc[ai][bj][m][0] * s, v1 = acc[ai][bj][m][1] * s;
                    u32x4 w; w.x = cvt_pk_bf16(v0[0], v0[1]); w.y = cvt_pk_bf16(v0[2], v0[3]); w.z = cvt_pk_bf16(v1[0], v1[1]); w.w = cvt_pk_bf16(v1[2], v1[3]);
                    *(u32x4*)(rowp + bj * HALF) = w; }
                asm volatile("" ::: "memory"); }
    }
};
}

#define XB_TMO      128
#define XB_XCNT(j)  (256  + 64 * (j))
#define XB_XSUB(j)  (1280 + 64 * (j))
#define XB_XGEN(j)  (2304 + 64 * (j))
#define XB_TOP      3328
#define XB_TOPGEN   3392
#define XB_SPIN_CAP (1u << 22)
DI unsigned xb_ld(unsigned* p)              { return __hip_atomic_load(p, __ATOMIC_RELAXED, __HIP_MEMORY_SCOPE_AGENT); }
DI unsigned xb_add(unsigned* p, unsigned v) { return __hip_atomic_fetch_add(p, v, __ATOMIC_RELAXED, __HIP_MEMORY_SCOPE_AGENT); }
DI unsigned xb_xcc_id() { return (unsigned)__builtin_amdgcn_s_getreg((3 << 11) | 20) & 0xFu; }
#define XB_SPIN(cond, bar) do { unsigned _sp = 0; while (cond) { __builtin_amdgcn_s_sleep(1); \
    if ((++_sp & 255u) == 0u) { if (xb_ld(&(bar)[XB_TMO])) break; if (_sp > XB_SPIN_CAP) { atomicAdd(&(bar)[XB_TMO], 1u); break; } } } } while (0)
struct XcdBarrier { unsigned* bar; unsigned x; volatile LAS unsigned* st; };
DI XcdBarrier xcd_barrier_post(unsigned* bar, volatile LAS unsigned* st) {
    XcdBarrier b; b.bar = bar; b.x = xb_xcc_id(); b.st = st;
    if (threadIdx.x == 0) (void)xb_add(&bar[XB_XCNT(b.x)], 1u);
    return b;
}
DI void xcd_barrier_complete(unsigned* bar, unsigned x, unsigned& nloc, unsigned& nx) {
    const unsigned G = gridDim.x * gridDim.y * gridDim.z;
    unsigned sum, cnt, mine, sp = 0u;
    for (;;) {
        sum = 0u; cnt = 0u; mine = 0u;
#pragma unroll
        for (unsigned j = 0; j < 16; ++j) { const unsigned c = xb_ld(&bar[XB_XCNT(j)]); sum += c; cnt += (c > 0u) ? 1u : 0u; mine = (j == x) ? c : mine; }
        if (sum == G) break;
        __builtin_amdgcn_s_sleep(1);
        if ((++sp & 255u) == 0u) { if (xb_ld(&bar[XB_TMO])) break; if (sp > XB_SPIN_CAP) { atomicAdd(&bar[XB_TMO], 1u); break; } }
    }
    nloc = mine > 0u ? mine : 1u; nx = cnt > 0u ? cnt : 1u;
}
DI void xcd_barrier(const XcdBarrier& b) {
    asm volatile("s_waitcnt vmcnt(0)" ::: "memory");
    __syncthreads();
    if (threadIdx.x == 0) {
        unsigned* bar = b.bar;
        __builtin_amdgcn_s_waitcnt(0);
        unsigned nloc = b.st[0], nx = b.st[1];
        if (nloc == 0u) { xcd_barrier_complete(bar, b.x, nloc, nx); b.st[0] = nloc; b.st[1] = nx; }
        const unsigned old = xb_add(&bar[XB_XSUB(b.x)], 1u);
        const unsigned gen = old / nloc;
        if (old + 1u == (gen + 1u) * nloc) {
            __builtin_amdgcn_fence(__ATOMIC_RELEASE, "agent");
            asm volatile("s_waitcnt vmcnt(0)" ::: "memory");
            const unsigned og = xb_add(&bar[XB_TOP], 1u);
            const unsigned tg = og / nx;
            if (og + 1u == (tg + 1u) * nx) xb_add(&bar[XB_TOPGEN], 1u);
            else XB_SPIN(xb_ld(&bar[XB_TOPGEN]) == tg, bar);
            __builtin_amdgcn_fence(__ATOMIC_ACQUIRE, "agent");
            xb_add(&bar[XB_XGEN(b.x)], 1u);
            asm volatile("s_waitcnt vmcnt(0)" ::: "memory");
        } else {
            XB_SPIN(xb_ld(&bar[XB_XGEN(b.x)]) == gen, bar);
            __builtin_amdgcn_fence(__ATOMIC_ACQUIRE, "agent");
            asm volatile("s_waitcnt vmcnt(0)" ::: "memory");
        }
    }
    __syncthreads();
}

struct Args { const void* in[21]; float* out; unsigned char* ws; int ph_lo, ph_hi, coop, pad; };

DI int qkperm(int d) { return 32 * ((d >> 4) & 3) + 8 * ((d >> 2) & 3) + 4 * (d >> 6) + (d & 3); }
DI int map_in(int n) {
    if (n < 2048) return n;
    if (n < 3584) { const int e = n - 2048; return 4096 + (e & ~127) + qkperm(e & 127); }
    if (n < 5120) { const int e = n - 3584; return 5632 + (e & ~127) + qkperm(e & 127); }
    if (n < 6656) return 7168 + (n - 5120);
    return 2048 + (n - 6656);
}
DI void transpose_item(const float* W, int K, int N, bf16_t* WT, const float* gk, int mapkind, LAS float* scr, int item, int lane) {
    const int nblk = N / 32, kb = item / nblk, nb = item % nblk, k0 = 64 * kb, n0 = 32 * nb;
#pragma unroll 8
    for (int i = 0; i < 32; ++i) { const int kk = 2 * i + (lane >> 5); float w = W[(size_t)(k0 + kk) * N + n0 + (lane & 31)]; if (gk) w *= gk[k0 + kk]; scr[kk * 33 + (lane & 31)] = w; }
    LDS_WAIT(); asm volatile("" ::: "memory");
    const int c = lane & 7;
#pragma unroll
    for (int j = 0; j < 4; ++j) { const int n = (lane >> 3) + 8 * j; const LAS float* s = scr + (8 * c) * 33 + n;
        u32x4 o; o.x = pk2(s[0 * 33], s[1 * 33]); o.y = pk2(s[2 * 33], s[3 * 33]); o.z = pk2(s[4 * 33], s[5 * 33]); o.w = pk2(s[6 * 33], s[7 * 33]);
        const int dst = mapkind ? map_in(n0 + n) : (n0 + n);
        *(u32x4*)(WT + (size_t)dst * K + k0 + 8 * c) = o; }
    LDS_WAIT(); asm volatile("" ::: "memory");
}
DI void convert_weights(const Args& a, int l, int mask, LAS unsigned char* lds, int gw, int NGW, int wave, int lane) {
    LAS float* scr = (LAS float*)(lds + wave * 8448);
    unsigned char* ws = a.ws;
    constexpr int I_IN = 16 * 272, I_LRU = 8 * 8, I_DN = 48 * 32, I_PR = 16 * 32, I_PA = 8 * 32, I_WO = 16 * 32, I_UP = 16 * 192;
    const int total = ((mask & 1) ? I_IN : 0) + ((mask & 2) ? 2 * I_LRU : 0) + ((mask & 4) ? I_DN : 0) + ((mask & 8) ? (I_PR + I_PA + I_WO + I_UP) : 0);
    for (int it = gw; it < total; it += NGW) {
        int r = it;
        if (mask & 1) { if (r < I_IN) { transpose_item((const float*)a.in[3] + (size_t)l * DM * NIN, DM, NIN, (bf16_t*)(ws + WS_W1T), (const float*)a.in[2] + l * DM, 1, scr, r, lane); continue; } r -= I_IN; }
        if (mask & 2) {
            if (r < I_LRU) { const int blk = r >> 3; transpose_item((const float*)a.in[6] + (size_t)l * 131072 + blk * 16384, 128, 128, (bf16_t*)(ws + WS_WAT) + blk * 16384, nullptr, 0, scr, r & 7, lane); continue; } r -= I_LRU;
            if (r < I_LRU) { const int blk = r >> 3; transpose_item((const float*)a.in[8] + (size_t)l * 131072 + blk * 16384, 128, 128, (bf16_t*)(ws + WS_WXT) + blk * 16384, nullptr, 0, scr, r & 7, lane); continue; } r -= I_LRU; }
        if (mask & 4) { if (r < I_DN) { transpose_item((const float*)a.in[20] + (size_t)l * DFF * DM, DFF, DM, (bf16_t*)(ws + WS_WDT), nullptr, 0, scr, r, lane); continue; } r -= I_DN; }
        if (mask & 8) {
            if (r < I_PR) { transpose_item((const float*)a.in[13] + (size_t)l * DM * DM, DM, DM, (bf16_t*)(ws + WS_PRT), nullptr, 0, scr, r, lane); continue; } r -= I_PR;
            if (r < I_PA) { transpose_item((const float*)a.in[14] + (size_t)l * 512 * DM, 512, DM, (bf16_t*)(ws + WS_PAT), nullptr, 0, scr, r, lane); continue; } r -= I_PA;
            if (r < I_WO) { transpose_item((const float*)a.in[15] + (size_t)l * DM * DM, DM, DM, (bf16_t*)(ws + WS_WOT), nullptr, 0, scr, r, lane); continue; } r -= I_WO;
            transpose_item((const float*)a.in[17] + (size_t)l * DM * NUP, DM, NUP, (bf16_t*)(ws + WS_WUT), (const float*)a.in[16] + l * DM, 0, scr, r, lane); }
    }
}

DI void p0_rows(const Args& a, int gw, int NGW, int lane) {
    const float* x = (const float*)a.in[0]; bf16_t* XB = (bf16_t*)(a.ws + WS_XB); float* ssp = (float*)(a.ws + WS_SSP);
    for (int m = gw; m < T; m += NGW) {
        const f32x4* xr = (const f32x4*)(x + (size_t)m * DM) + lane; f32x4 v[4]; float s = 0.f;
#pragma unroll
        for (int j = 0; j < 4; ++j) { v[j] = xr[64 * j]; s += (v[j].x * v[j].x + v[j].y * v[j].y) + (v[j].z * v[j].z + v[j].w * v[j].w); }
#pragma unroll
        for (int o = 1; o < 64; o <<= 1) s += __shfl_xor(s, o);
        u32x2* o8 = (u32x2*)(XB + (size_t)m * DM) + lane;
#pragma unroll
        for (int j = 0; j < 4; ++j) { u32x2 w; w.x = pk2(v[j].x, v[j].y); w.y = pk2(v[j].z, v[j].w); o8[64 * j] = w; }
        if (lane < 16) ssp[(size_t)m * 16 + lane] = (lane == 0) ? s : 0.f;
    }
}
DI void p0_rope(const Args& a, int gtid, int nthr) {
    const int* pos = (const int*)a.in[1]; float* cosT = (float*)(a.ws + WS_COS); float* sinT = (float*)(a.ws + WS_SIN);
    for (int i = gtid; i < T * 64; i += nthr) {
        const int t = i >> 6, f = i & 63;
        const float inv = exp2f(-(float)f * (13.287712379549449f / 64.0f));
        const float ang = (float)pos[t] * inv;
        const double ad = (double)ang; const double kk = __builtin_rint(ad * 0.15915494309189535); const float r = (float)(ad - kk * 6.283185307179586);
        cosT[i] = __cosf(r); sinT[i] = __sinf(r);
    }
}

#define MFMA32(a, b, c) __builtin_amdgcn_mfma_f32_32x32x16_bf16((a), (b), (c), 0, 0, 0)
DI void lru_item(const Args& a, int l, LAS unsigned char* lds, int item, int tid, int wave, int lane) {
    unsigned char* ws = a.ws;
    const int b = item >> 8, n = (item >> 5) & 7, ck = item & 31;
    const int t0 = b * SEQ + ck * 64, c0 = n * 128;
    const bf16_t* XR = (const bf16_t*)(ws + WS_AR + AR_XR);
    LAS unsigned char* XCb = lds;
    LAS float* XCF = (LAS float*)(lds + 17408);
    LAS float* AA = (LAS float*)(lds + 17408 + 32768);
    {
        const int cg8 = tid & 15, tr = tid >> 4, c = c0 + 8 * cg8;
        const float* cw = (const float*)a.in[4] + (size_t)l * 4 * DM + c; const float* cb = (const float*)a.in[5] + (size_t)l * DM + c;
        float w[4][8], bb[8];
#pragma unroll
        for (int i = 0; i < 4; ++i) { const f32x4 w0 = *(const f32x4*)(cw + i * DM), w1 = *(const f32x4*)(cw + i * DM + 4);
#pragma unroll
            for (int e = 0; e < 4; ++e) { w[i][e] = w0[e]; w[i][4 + e] = w1[e]; } }
        { const f32x4 b0 = *(const f32x4*)cb, b1 = *(const f32x4*)(cb + 4);
#pragma unroll
          for (int e = 0; e < 4; ++e) { bb[e] = b0[e]; bb[4 + e] = b1[e]; } }
#pragma unroll
        for (int j = 0; j < 2; ++j) { const int tl = tr + 32 * j, tp = ck * 64 + tl; float o[8];
#pragma unroll
            for (int e = 0; e < 8; ++e) o[e] = bb[e];
#pragma unroll
            for (int i = 0; i < 4; ++i) { const int p = tp - 3 + i;
                if (p >= 0) { const u32x4 v = *(const u32x4*)(XR + (size_t)(b * SEQ + p) * DM + c);
                    o[0] += w[i][0] * bflo(v.x); o[1] += w[i][1] * bfhi(v.x); o[2] += w[i][2] * bflo(v.y); o[3] += w[i][3] * bfhi(v.y);
                    o[4] += w[i][4] * bflo(v.z); o[5] += w[i][5] * bfhi(v.z); o[6] += w[i][6] * bflo(v.w); o[7] += w[i][7] * bfhi(v.w); } }
            *(LAS f32x4*)(XCF + tl * 128 + 8 * cg8) = (f32x4){o[0], o[1], o[2], o[3]}; *(LAS f32x4*)(XCF + tl * 128 + 8 * cg8 + 4) = (f32x4){o[4], o[5], o[6], o[7]};
            u32x4 pw; pw.x = pk2(o[0], o[1]); pw.y = pk2(o[2], o[3]); pw.z = pk2(o[4], o[5]); pw.w = pk2(o[6], o[7]);
            *(LAS u32x4*)(XCb + tl * 272 + 16 * cg8) = pw; }
    }
    __syncthreads();
    {
        const int r = lane & 31, h = lane >> 5;
        const bf16_t* wrow = (r < 16) ? (const bf16_t*)(ws + WS_WAT) + n * 16384 + (16 * wave + r) * 128 : (const bf16_t*)(ws + WS_WXT) + n * 16384 + (16 * wave + r - 16) * 128;
        bf16x8 bfr[8];
#pragma unroll
        for (int ks = 0; ks < 8; ++ks) bfr[ks] = *(const bf16x8*)(wrow + 16 * ks + 8 * h);
        const int cl = 16 * wave + (r & 15); const bool isI = r >= 16;
        const float bias = isI ? ((const float*)a.in[9])[(size_t)l * DM + c0 + cl] : ((const float*)a.in[7])[(size_t)l * DM + c0 + cl];
        const float lam = ((const float*)a.in[10])[(size_t)l * DM + c0 + cl];
        const float sp8 = 8.0f * log1pf(expf(-lam));
#pragma unroll
        for (int rt = 0; rt < 2; ++rt) {
            f32x16 acc;
#pragma unroll
            for (int i = 0; i < 16; ++i) acc[i] = 0.f;
#pragma unroll
            for (int ks = 0; ks < 8; ++ks) { const bf16x8 af = *(const LAS bf16x8*)(XCb + (32 * rt + r) * 272 + (16 * ks + 8 * h) * 2); acc = MFMA32(af, bfr[ks], acc); }
#pragma unroll
            for (int i = 0; i < 16; ++i) { const int tl = 32 * rt + (i & 3) + 8 * (i >> 2) + 4 * h;
                const float gte = sigmoidf_(acc[i] + bias); const float oth = __shfl_xor(gte, 16);
                const float rg = isI ? oth : gte, ig = isI ? gte : oth;
                const float la = -sp8 * rg;
                if (!isI) AA[tl * 128 + cl] = expf(la);
                else { const float mult = sqrtf(-expm1f(2.0f * la)); const float xv = XCF[tl * 128 + cl]; XCF[tl * 128 + cl] = mult * (ig * xv); } }
        }
    }
    __syncthreads();
    if (wave < 4) {
        const int cl = 32 * wave + (lane & 31), sg = lane >> 5; const int tb = 32 * sg;
        float A = 1.f, H = 0.f;
#pragma unroll 8
        for (int s = 0; s < 32; ++s) { const float av = AA[(tb + s) * 128 + cl], uv = XCF[(tb + s) * 128 + cl]; H = av * H + uv; A *= av; }
        const float A0 = __shfl(A, lane & 31), H0 = __shfl(H, lane & 31);
        float hh = sg ? H0 : 0.f, Ac = sg ? A0 : 1.f;
        unsigned* HL = (unsigned*)(ws + WS_AR + AR_HL) + (size_t)(t0 + tb) * DM + c0 + cl;
#pragma unroll 8
        for (int s = 0; s < 32; ++s) { const float av = AA[(tb + s) * 128 + cl], uv = XCF[(tb + s) * 128 + cl]; hh = av * hh + uv; Ac *= av; HL[(size_t)s * DM] = pkh2(hh, Ac); }
        if (sg) { ((float*)(ws + WS_AGGA))[(size_t)(b * 32 + ck) * DM + c0 + cl] = Ac; ((float*)(ws + WS_AGGH))[(size_t)(b * 32 + ck) * DM + c0 + cl] = hh; }
    }
    __syncthreads();
}

DI bf16x8 pack8(const f32x16& x, int s) {
    u32x4 p; p.x = pk2(x[8 * s], x[8 * s + 1]); p.y = pk2(x[8 * s + 2], x[8 * s + 3]); p.z = pk2(x[8 * s + 4], x[8 * s + 5]); p.w = pk2(x[8 * s + 6], x[8 * s + 7]);
    return __builtin_bit_cast(bf16x8, p);
}
DI void attn_item(unsigned char* ws, int it, int lane) {
    const bf16_t* Q = (const bf16_t*)(ws + WS_AR + AR_Q); const bf16_t* Kp = (const bf16_t*)(ws + WS_AR + AR_K); const bf16_t* V = (const bf16_t*)(ws + WS_AR + AR_V);
    bf16_t* OG = (bf16_t*)(ws + WS_AR + AR_OG); float* LSE = (float*)(ws + WS_LSE);
    const int b = it / 768, r1 = it % 768, hd = r1 >> 6, qi = r1 & 63;
    const int sh = 2 * (hd >> 2), tps = 64 >> sh;
    const int rstream = qi / tps, m0 = 32 * (qi % tps);
    const int r = lane & 31, h = lane >> 5;
    const size_t qtok = (size_t)b * SEQ + ((size_t)(m0 + r) << sh) + rstream;
    const bf16_t* qrow = Q + qtok * AW + hd * 128 + 8 * h;
    bf16x8 qf[8];
#pragma unroll
    for (int ks = 0; ks < 8; ++ks) qf[ks] = *(const bf16x8*)(qrow + 16 * ks);
    bf16x8 idf[2];
#pragma unroll
    for (int e = 0; e < 2; ++e)
#pragma unroll
        for (int j = 0; j < 8; ++j) idf[e][j] = (16 * e + 8 * h + j == r) ? (short)0x3F80 : (short)0;
    f32x16 O[4];
#pragma unroll
    for (int dt = 0; dt < 4; ++dt)
#pragma unroll
        for (int i = 0; i < 16; ++i) O[dt][i] = 0.f;
    float mrun = -1e30f, lpart = 0.f;
    constexpr float L2E = 1.4426950408889634f;
    for (int kt = 0; kt < 5; ++kt) {
        const int kb = m0 - 128 + 32 * kt;
        if (kb < 0) continue;
        const size_t ktok = (size_t)b * SEQ + ((size_t)(kb + r) << sh) + rstream;
        const bf16_t* krow = Kp + ktok * AW + hd * 128 + 8 * h; const bf16_t* vrow = V + ktok * AW + hd * 128 + 8 * h;
        bf16x8 kf[8], vf[8];
#pragma unroll
        for (int ks = 0; ks < 8; ++ks) kf[ks] = *(const bf16x8*)(krow + 16 * ks);
#pragma unroll
        for (int ks = 0; ks < 8; ++ks) vf[ks] = *(const bf16x8*)(vrow + 16 * ks);
        f32x16 Sx;
#pragma unroll
        for (int i = 0; i < 16; ++i) Sx[i] = 0.f;
#pragma unroll
        for (int ks = 0; ks < 8; ++ks) Sx = MFMA32(kf[ks], qf[ks], Sx);
        float mx = -1e30f;
#pragma unroll
        for (int i = 0; i < 16; ++i) { const int ki = (i & 3) + 8 * (i >> 2) + 4 * h;
            if ((kt == 0 && ki < r) || (kt == 4 && ki > r)) Sx[i] = -1e30f;
            mx = fmaxf(mx, Sx[i]); }
        mx = fmaxf(mx, __shfl_xor(mx, 32));
        const float mnew = fmaxf(mrun, mx), alpha = exp2f((mrun - mnew) * L2E);
        float ps = 0.f;
#pragma unroll
        for (int i = 0; i < 16; ++i) { Sx[i] = exp2f((Sx[i] - mnew) * L2E); ps += Sx[i]; }
        lpart = lpart * alpha + ps; mrun = mnew;
        const bf16x8 pf0 = pack8(Sx, 0), pf1 = pack8(Sx, 1);
#pragma unroll
        for (int dt = 0; dt < 4; ++dt) {
            f32x16 X;
#pragma unroll
            for (int i = 0; i < 16; ++i) X[i] = 0.f;
            X = MFMA32(vf[2 * dt], idf[0], X); X = MFMA32(vf[2 * dt + 1], idf[1], X);
            const bf16x8 xf0 = pack8(X, 0), xf1 = pack8(X, 1);
#pragma unroll
            for (int i = 0; i < 16; ++i) O[dt][i] *= alpha;
            O[dt] = MFMA32(xf0, pf0, O[dt]); O[dt] = MFMA32(xf1, pf1, O[dt]);
        }
    }
    const float ltot = lpart + __shfl_xor(lpart, 32), inv = 1.0f / ltot;
    bf16_t* orow = OG + qtok * AW + hd * 128 + 4 * h;
#pragma unroll
    for (int dt = 0; dt < 4; ++dt)
#pragma unroll
        for (int gq = 0; gq < 4; ++gq) { u32x2 w; w.x = pk2(O[dt][4 * gq] * inv, O[dt][4 * gq + 1] * inv); w.y = pk2(O[dt][4 * gq + 2] * inv, O[dt][4 * gq + 3] * inv);
            *(u32x2*)(orow + 32 * dt + 8 * gq) = w; }
    if (h == 0) LSE[qtok * 12 + hd] = mrun + logf(ltot);
}

DI void b2_fix(const Args& a, int tid) {
    unsigned char* ws = a.ws;
    const float* AGA = (const float*)(ws + WS_AGGA); const float* AGH = (const float*)(ws + WS_AGGH);
    const unsigned* HL = (const unsigned*)(ws + WS_AR + AR_HL); const bf16_t* GG = (const bf16_t*)(ws + WS_AR + AR_GG); bf16_t* YR = (bf16_t*)(ws + WS_AR + AR_YR);
    for (int it = blockIdx.x; it < 256; it += gridDim.x) {
        const int b = it >> 5, ck = it & 31, c = 4 * (tid & 255), th = tid >> 8;
        f32x4 carry = {0.f, 0.f, 0.f, 0.f};
        for (int j = 0; j < ck; ++j) { const f32x4 A = *(const f32x4*)(AGA + (size_t)(b * 32 + j) * DM + c), H = *(const f32x4*)(AGH + (size_t)(b * 32 + j) * DM + c); carry = A * carry + H; }
        const size_t tb = (size_t)b * SEQ + ck * 64 + 32 * th;
#pragma unroll 4
        for (int s = 0; s < 32; ++s) { const size_t off = (tb + s) * DM + c;
            const u32x4 hl = *(const u32x4*)(HL + off); const u32x2 gg = *(const u32x2*)(GG + off);
            const float y0 = (hlo(hl.x) + hhi(hl.x) * carry[0]) * bflo(gg.x), y1 = (hlo(hl.y) + hhi(hl.y) * carry[1]) * bfhi(gg.x);
            const float y2 = (hlo(hl.z) + hhi(hl.z) * carry[2]) * bflo(gg.y), y3 = (hlo(hl.w) + hhi(hl.w) * carry[3]) * bfhi(gg.y);
            u32x2 w; w.x = pk2(y0, y1); w.y = pk2(y2, y3); *(u32x2*)(YR + off) = w; }
    }
}
DI void b2_merge(unsigned char* ws, int gtid, int nthr) {
    const bf16_t* OG = (const bf16_t*)(ws + WS_AR + AR_OG); const float* LSE = (const float*)(ws + WS_LSE); bf16_t* YA = (bf16_t*)(ws + WS_AR + AR_YA);
    for (int i = gtid; i < T * 64; i += nthr) {
        const int t = i >> 6, j = (i >> 4) & 3, d8 = i & 15;
        const float l0 = LSE[(size_t)t * 12 + j], l1 = LSE[(size_t)t * 12 + 4 + j], l2 = LSE[(size_t)t * 12 + 8 + j];
        const float mx = fmaxf(l0, fmaxf(l1, l2)); const float e0 = __expf(l0 - mx), e1 = __expf(l1 - mx), e2 = __expf(l2 - mx); const float inv = 1.0f / (e0 + e1 + e2);
        const float w0 = e0 * inv, w1 = e1 * inv, w2 = e2 * inv;
        const bf16_t* op = OG + (size_t)t * AW + j * 128 + 8 * d8;
        const u32x4 o0 = *(const u32x4*)op, o1 = *(const u32x4*)(op + 512), o2 = *(const u32x4*)(op + 1024);
        u32x4 w;
        w.x = pk2(w0 * bflo(o0.x) + w1 * bflo(o1.x) + w2 * bflo(o2.x), w0 * bfhi(o0.x) + w1 * bfhi(o1.x) + w2 * bfhi(o2.x));
        w.y = pk2(w0 * bflo(o0.y) + w1 * bflo(o1.y) + w2 * bflo(o2.y), w0 * bfhi(o0.y) + w1 * bfhi(o1.y) + w2 * bfhi(o2.y));
        w.z = pk2(w0 * bflo(o0.z) + w1 * bflo(o1.z) + w2 * bflo(o2.z), w0 * bfhi(o0.z) + w1 * bfhi(o1.z) + w2 * bfhi(o2.z));
        w.w = pk2(w0 * bflo(o0.w) + w1 * bflo(o1.w) + w2 * bflo(o2.w), w0 * bfhi(o0.w) + w1 * bfhi(o1.w) + w2 * bfhi(o2.w));
        *(u32x4*)(YA + (size_t)t * 512 + j * 128 + 8 * d8) = w;
    }
}

DI void e2_convact(const Args& a, int l, int gtid, int nthr) {
    unsigned char* ws = a.ws;
    const bf16_t* U = (const bf16_t*)(ws + WS_AR + AR_U); bf16_t* ACT = (bf16_t*)(ws + WS_AR + AR_ACT);
    const float* cw = (const float*)a.in[18] + (size_t)l * 3 * NUP; const float* cb = (const float*)a.in[19] + (size_t)l * NUP;
    for (int i = gtid; i < 1024 * 384; i += nthr) {
        const int c8 = i % 384, run = i / 384, c = 8 * c8; const int tstart = run * 16, p0 = tstart & (SEQ - 1);
        float wg[3][8], wv[3][8], bg[8], bv[8];
#pragma unroll
        for (int k = 0; k < 3; ++k) { const f32x4 g0 = *(const f32x4*)(cw + k * NUP + c), g1 = *(const f32x4*)(cw + k * NUP + c + 4), v0 = *(const f32x4*)(cw + k * NUP + DFF + c), v1 = *(const f32x4*)(cw + k * NUP + DFF + c + 4);
#pragma unroll
            for (int e = 0; e < 4; ++e) { wg[k][e] = g0[e]; wg[k][4 + e] = g1[e]; wv[k][e] = v0[e]; wv[k][4 + e] = v1[e]; } }
        { const f32x4 g0 = *(const f32x4*)(cb + c), g1 = *(const f32x4*)(cb + c + 4), v0 = *(const f32x4*)(cb + DFF + c), v1 = *(const f32x4*)(cb + DFF + c + 4);
#pragma unroll
          for (int e = 0; e < 4; ++e) { bg[e] = g0[e]; bg[4 + e] = g1[e]; bv[e] = v0[e]; bv[4 + e] = v1[e]; } }
        float g2[8], g1r[8], v2[8], v1r[8];
#pragma unroll
        for (int e = 0; e < 8; ++e) { g2[e] = 0.f; g1r[e] = 0.f; v2[e] = 0.f; v1r[e] = 0.f; }
        if (p0 >= 2) {
            const u32x4 ga = *(const u32x4*)(U + (size_t)(tstart - 2) * NUP + c), gb = *(const u32x4*)(U + (size_t)(tstart - 1) * NUP + c);
            const u32x4 va = *(const u32x4*)(U + (size_t)(tstart - 2) * NUP + DFF + c), vb = *(const u32x4*)(U + (size_t)(tstart - 1) * NUP + DFF + c);
            g2[0] = bflo(ga.x); g2[1] = bfhi(ga.x); g2[2] = bflo(ga.y); g2[3] = bfhi(ga.y); g2[4] = bflo(ga.z); g2[5] = bfhi(ga.z); g2[6] = bflo(ga.w); g2[7] = bfhi(ga.w);
            g1r[0] = bflo(gb.x); g1r[1] = bfhi(gb.x); g1r[2] = bflo(gb.y); g1r[3] = bfhi(gb.y); g1r[4] = bflo(gb.z); g1r[5] = bfhi(gb.z); g1r[6] = bflo(gb.w); g1r[7] = bfhi(gb.w);
            v2[0] = bflo(va.x); v2[1] = bfhi(va.x); v2[2] = bflo(va.y); v2[3] = bfhi(va.y); v2[4] = bflo(va.z); v2[5] = bfhi(va.z); v2[6] = bflo(va.w); v2[7] = bfhi(va.w);
            v1r[0] = bflo(vb.x); v1r[1] = bfhi(vb.x); v1r[2] = bflo(vb.y); v1r[3] = bfhi(vb.y); v1r[4] = bflo(vb.z); v1r[5] = bfhi(vb.z); v1r[6] = bflo(vb.w); v1r[7] = bfhi(vb.w);
        }
#pragma unroll 4
        for (int s = 0; s < 16; ++s) {
            const u32x4 gc = *(const u32x4*)(U + (size_t)(tstart + s) * NUP + c), vc = *(const u32x4*)(U + (size_t)(tstart + s) * NUP + DFF + c);
            float g0[8], v0[8];
            g0[0] = bflo(gc.x); g0[1] = bfhi(gc.x); g0[2] = bflo(gc.y); g0[3] = bfhi(gc.y); g0[4] = bflo(gc.z); g0[5] = bfhi(gc.z); g0[6] = bflo(gc.w); g0[7] = bfhi(gc.w);
            v0[0] = bflo(vc.x); v0[1] = bfhi(vc.x); v0[2] = bflo(vc.y); v0[3] = bfhi(vc.y); v0[4] = bflo(vc.z); v0[5] = bfhi(vc.z); v0[6] = bflo(vc.w); v0[7] = bfhi(vc.w);
            float o[8];
#pragma unroll
            for (int e = 0; e < 8; ++e) { const float ug = bg[e] + wg[0][e] * g2[e] + wg[1][e] * g1r[e] + wg[2][e] * g0[e]; const float uv = bv[e] + wv[0][e] * v2[e] + wv[1][e] * v1r[e] + wv[2][e] * v0[e];
                o[e] = gelu_tanh(ug) * uv; g2[e] = g1r[e]; g1r[e] = g0[e]; v2[e] = v1r[e]; v1r[e] = v0[e]; }
            u32x4 w; w.x = pk2(o[0], o[1]); w.y = pk2(o[2], o[3]); w.z = pk2(o[4], o[5]); w.w = pk2(o[6], o[7]);
            *(u32x4*)(ACT + (size_t)(tstart + s) * DFF + c) = w;
        }
    }
}

constexpr int NPHASE = 1 + 8 * DEPTH;
__global__ void __launch_bounds__(512, 2) mega(Args a) {
    extern __shared__ __attribute__((aligned(16))) unsigned char lds_raw[];
    LAS unsigned char* lds = (LAS unsigned char*)lds_raw;
    const int G = gridDim.x, NGW = G * 8, nthr = G * 512;
    unsigned char* ws = a.ws;
    volatile LAS unsigned* MISC = (volatile LAS unsigned*)(lds + MISC_OFF);
    if (threadIdx.x < 64) MISC[threadIdx.x] = 0u;
    __syncthreads();
    XcdBarrier bar; bar.bar = (unsigned*)(ws + WS_CTL); bar.x = 0; bar.st = MISC + 8;
    if (a.coop && !USE_CG_SYNC) bar = xcd_barrier_post((unsigned*)(ws + WS_CTL), MISC + 8);

    for (int ph = a.ph_lo; ph < a.ph_hi; ++ph) {
        int tid = threadIdx.x; asm volatile("" : "+v"(tid));
        const int lane = tid & 63, wave = __builtin_amdgcn_readfirstlane(tid >> 6);
        const int gw = blockIdx.x * 8 + wave, gtid = blockIdx.x * 512 + tid;
        if (ph == 0) {
          if (PHASE_MASK & 1) {
            convert_weights(a, 0, 15, lds, gw, NGW, wave, lane);
            p0_rows(a, gw, NGW, lane);
            p0_rope(a, gtid, nthr);
          }
        } else {
            const int l = (ph - 1) >> 3, sub = (ph - 1) & 7;
            float* xout = a.out;
            bf16_t* XB = (bf16_t*)(ws + WS_XB); float* ssp = (float*)(ws + WS_SSP);
            if (sub == 0 && (PHASE_MASK & 2)) {
                pg8::Gemm g{XB, (const bf16_t*)(ws + WS_W1T), T, NIN, DM}; pg8::StaticOrder S; S.init(T, NIN, G, (int)blockIdx.x);
                pg8::EpiIn E{ssp, (bf16_t*)(ws + WS_AR + AR_XR), (bf16_t*)(ws + WS_AR + AR_GG), (bf16_t*)(ws + WS_AR + AR_SGR), (bf16_t*)(ws + WS_AR + AR_SGA),
                             (bf16_t*)(ws + WS_AR + AR_Q), (bf16_t*)(ws + WS_AR + AR_K), (bf16_t*)(ws + WS_AR + AR_V),
                             (const float*)a.in[11] + (size_t)l * AW, (const float*)a.in[12] + (size_t)l * AW, (const float*)(ws + WS_COS), (const float*)(ws + WS_SIN), (LAS float*)(lds + TAB_OFF)};
                pg8::gemm_phase(lds, g, S, E);
            } else if (sub == 1 && (PHASE_MASK & 4)) {
                for (int it = blockIdx.x; it < 2048; it += G) lru_item(a, l, lds, it, tid, wave, lane);
                for (int it = gw; it < NBATCH * 12 * 64; it += NGW) attn_item(ws, it, lane);
            } else if (sub == 2 && (PHASE_MASK & 8)) {
                b2_fix(a, tid);
                b2_merge(ws, gtid, nthr);
                if (l + 1 < DEPTH) convert_weights(a, l + 1, 3, lds, gw, NGW, wave, lane);
                if (l >= 1) convert_weights(a, l, 4, lds, gw, NGW, wave, lane);
            } else if (sub == 3 && (PHASE_MASK & 16)) {
                { pg8::Gemm g{(const bf16_t*)(ws + WS_AR + AR_YR), (const bf16_t*)(ws + WS_PRT), T, DM, DM}; pg8::StaticOrder S; S.init(T, DM, G, (int)blockIdx.x);
                  pg8::EpiProj1 E{(const bf16_t*)(ws + WS_AR + AR_SGR), (float*)(ws + WS_AR + AR_TMP)}; pg8::gemm_phase(lds, g, S, E); }
                { pg8::Gemm g{(const bf16_t*)(ws + WS_AR + AR_YA), (const bf16_t*)(ws + WS_PAT), T, DM, 512}; pg8::StaticOrder S; S.init(T, DM, G, (int)blockIdx.x);
                  pg8::EpiProj2 E{(const bf16_t*)(ws + WS_AR + AR_SGA), (const float*)(ws + WS_AR + AR_TMP), (bf16_t*)(ws + WS_AR + AR_MG)}; pg8::gemm_phase(lds, g, S, E); }
            } else if (sub == 4 && (PHASE_MASK & 32)) {
                pg8::Gemm g{(const bf16_t*)(ws + WS_AR + AR_MG), (const bf16_t*)(ws + WS_WOT), T, DM, DM}; pg8::StaticOrder S; S.init(T, DM, G, (int)blockIdx.x);
                pg8::EpiResid E{l == 0 ? (const float*)a.in[0] : (const float*)xout, xout, XB, ssp}; pg8::gemm_phase(lds, g, S, E);
            } else if (sub == 5 && (PHASE_MASK & 64)) {
                pg8::Gemm g{XB, (const bf16_t*)(ws + WS_WUT), T, NUP, DM}; pg8::StaticOrder S; S.init(T, NUP, G, (int)blockIdx.x);
                pg8::EpiUp E{ssp, (bf16_t*)(ws + WS_AR + AR_U)}; pg8::gemm_phase(lds, g, S, E);
            } else if (sub == 6 && (PHASE_MASK & 128)) {
                e2_convact(a, l, gtid, nthr);
                if (l + 1 < DEPTH) convert_weights(a, l + 1, 8, lds, gw, NGW, wave, lane);
            } else if (sub == 7 && (PHASE_MASK & 256)) {
                pg8::Gemm g{(const bf16_t*)(ws + WS_AR + AR_ACT), (const bf16_t*)(ws + WS_WDT), T, DM, DFF}; pg8::StaticOrder S; S.init(T, DM, G, (int)blockIdx.x);
                pg8::EpiResid E{(const float*)xout, xout, XB, ssp}; pg8::gemm_phase(lds, g, S, E);
            }
        }
        if (ph + 1 < a.ph_hi) {
            if (USE_CG_SYNC || ph == 0) { cg::this_grid().sync(); }
            else xcd_barrier(bar);
        }
    }
}

extern "C" void kernel_launch(void* const* d_in, const int* in_sizes, int n_in, void* d_out, int out_size, void* d_ws, size_t ws_size, hipStream_t stream) {
    static int grid = 0;
    if (grid == 0) {
        if (n_in != 21 || out_size != T * DM || ws_size < WS_END) { fprintf(stderr, "kernel_launch: unexpected shapes (n_in %d out %d ws %zu, need %zu)\n", n_in, out_size, ws_size, (size_t)WS_END); grid = -1; return; }
        int dev = 0, cus = 0, per_cu = 0;
        hipGetDevice(&dev); hipDeviceGetAttribute(&cus, hipDeviceAttributeMultiprocessorCount, dev);
        if (hipFuncSetAttribute((const void*)mega, hipFuncAttributeMaxDynamicSharedMemorySize, LDS_BYTES) != hipSuccess) { fprintf(stderr, "kernel_launch: hipFuncSetAttribute failed\n"); grid = -1; return; }
        if (hipOccupancyMaxActiveBlocksPerMultiprocessor(&per_cu, (const void*)mega, 512, LDS_BYTES) != hipSuccess || per_cu < 1) { fprintf(stderr, "kernel_launch: occupancy query says %d\n", per_cu); per_cu = 1; }
        (void)hipGetLastError();
        grid = cus * 1;
        fprintf(stderr, "kernel_launch: grid %d (cus %d, per_cu %d)\n", grid, cus, per_cu);
    }
    if (grid < 0) return;
    Args a{};
    for (int i = 0; i < 21; ++i) a.in[i] = d_in[i];
    a.out = (float*)d_out; a.ws = (unsigned char*)d_ws; a.pad = 0;
#if MK_MULTI
    for (int p = 0; p < DBG_NPH; ++p) { a.ph_lo = p; a.ph_hi = p + 1; a.coop = 0; hipLaunchKernelGGL(mega, dim3(grid), dim3(512), LDS_BYTES, stream, a); }
#else
    hipMemsetAsync((char*)d_ws + WS_CTL, 0, CTL_BYTES, stream);
    a.ph_lo = 0; a.ph_hi = NPHASE; a.coop = 1;
    void* args[] = {&a};
    hipError_t e = hipLaunchCooperativeKernel((const void*)mega, dim3(grid), dim3(512), args, LDS_BYTES, stream);
    if (e != hipSuccess) fprintf(stderr, "kernel_launch: cooperative launch failed: %s (grid %d)\n", hipGetErrorString(e), grid);
#endif
}
```

```cpp
#include <hip/hip_runtime.h>
#include <hip/hip_cooperative_groups.h>
#include <cstdio>
namespace cg = cooperative_groups;

#ifndef MK_MULTI
#define MK_MULTI 0
#endif
#ifndef PHASE_MASK
#define PHASE_MASK 0x1ff
#endif
#ifndef DBG_NPH
#define DBG_NPH 33
#endif
#ifndef USE_CG_SYNC
#define USE_CG_SYNC 0
#endif

#define DI __device__ __forceinline__
#define LAS __attribute__((address_space(3)))
typedef unsigned short bf16_t;
typedef short bf16x8 __attribute__((ext_vector_type(8)));
typedef float f32x2 __attribute__((ext_vector_type(2)));
typedef float f32x4 __attribute__((ext_vector_type(4)));
typedef float f32x16 __attribute__((ext_vector_type(16)));
typedef unsigned u32x2 __attribute__((ext_vector_type(2)));
typedef unsigned u32x4 __attribute__((ext_vector_type(4)));
typedef __bf16 bf16x2v __attribute__((ext_vector_type(2)));

constexpr int T = 16384, SEQ = 2048, NBATCH = 8, DEPTH = 4;
constexpr int DM = 1024, NIN = 8704, AW = 1536, DFF = 3072, NUP = 6144;
constexpr float EPS = 1e-6f;

constexpr size_t MiB = 1u << 20;
constexpr size_t WS_CTL = 0, CTL_BYTES = 1 * MiB;
constexpr size_t WS_SSP = 1 * MiB;
constexpr size_t WS_AGGA = 2 * MiB, WS_AGGH = 3 * MiB;
constexpr size_t WS_LSE = 4 * MiB;
constexpr size_t WS_COS = 5 * MiB, WS_SIN = 9 * MiB;
constexpr size_t WS_W1T = 13 * MiB;
constexpr size_t WS_WUT = 30 * MiB;
constexpr size_t WS_WDT = 42 * MiB;
constexpr size_t WS_PRT = 48 * MiB;
constexpr size_t WS_PAT = 50 * MiB;
constexpr size_t WS_WOT = 51 * MiB;
constexpr size_t WS_WAT = 53 * MiB;
constexpr size_t WS_WXT = 53 * MiB + 262144;
constexpr size_t WS_XB = 54 * MiB;
constexpr size_t WS_AR = 86 * MiB;
constexpr size_t AR_XR = 0, AR_YR = 0;
constexpr size_t AR_GG = 32 * MiB, AR_MG = 32 * MiB;
constexpr size_t AR_SGR = 64 * MiB, AR_SGA = 96 * MiB;
constexpr size_t AR_Q = 128 * MiB, AR_K = 176 * MiB, AR_V = 224 * MiB;
constexpr size_t AR_YA = 128 * MiB, AR_TMP = 144 * MiB;
constexpr size_t AR_HL = 272 * MiB, AR_OG = 336 * MiB;
constexpr size_t AR_U = 0, AR_ACT = 192 * MiB;
constexpr size_t WS_END = WS_AR + 384 * MiB;

constexpr int RING_BYTES = 131072;
constexpr int TAB_OFF = RING_BYTES;
constexpr int MISC_OFF = RING_BYTES + 8192;
constexpr int LDS_BYTES = 147456;

#define LDS_WAIT() asm volatile("s_waitcnt lgkmcnt(0)" ::: "memory")
DI unsigned f2bf(float f) { unsigned u = __builtin_bit_cast(unsigned, f); return (u + 0x7fffu + ((u >> 16) & 1u)) >> 16; }
DI unsigned pk2(float lo, float hi) { f32x2 v = {lo, hi}; return __builtin_bit_cast(unsigned, __builtin_convertvector(v, bf16x2v)); }
DI float bflo(unsigned w) { return __builtin_bit_cast(float, w << 16); }
DI float bfhi(unsigned w) { return __builtin_bit_cast(float, w & 0xffff0000u); }
DI float sigmoidf_(float x) { return 1.0f / (1.0f + __expf(-x)); }
DI float gelu_tanh(float x) { const float y = 1.5957691216057308f * (x + 0.044715f * x * x * x); return x / (1.0f + __expf(-y)); }
DI unsigned pkh2(float lo, float hi) { const _Float16 a = (_Float16)lo, b = (_Float16)hi; return (unsigned)__builtin_bit_cast(unsigned short, a) | ((unsigned)__builtin_bit_cast(unsigned short, b) << 16); }
DI float hlo(unsigned w) { return (float)__builtin_bit_cast(_Float16, (unsigned short)(w & 0xffffu)); }
DI float hhi(unsigned w) { return (float)__builtin_bit_cast(_Float16, (unsigned short)(w >> 16)); }

namespace pg8 {
constexpr int BM = 256, BK = 64, HALF = 128, HTB = HALF * BK * 2, NXCD = 8, WGM = 8;
DI int lds_byte(int r, int c) { const int st = (r >> 4) * 2 + (c >> 5), rr = r & 15, cc = c & 31, ob = rr * 64 + cc * 2; return st * 1024 + (ob ^ (((ob >> 9) & 1) << 5)); }
DI void stage_rc(int b, int& R, int& C) { const int st = b / 1024, sb = b % 1024, swz = sb ^ (((sb >> 9) & 1) << 5); R = (st >> 1) * 16 + swz / 64; C = (st & 1) * 32 + (swz % 64) / 2; }
DI int perm32(int rho) { const int n = rho >> 4, i = rho & 15; return 8 * (i >> 2) + 4 * n + (i & 3); }
struct Unit { int pm, pn; };
struct Gemm { const bf16_t* A; const bf16_t* Bt; int M, N, K; };
struct StaticOrder {
    int nM, nN, nwg, G, c;
    DI void init(int M, int N, int G_, int c_) { nM = M / BM; nN = N / BM; nwg = nM * nN; G = G_; c = c_; }
    DI bool next(int i, Unit& u) const {
        const long L = (long)i * G + c; if (L >= nwg) return false;
        int wgid = (int)L; { const int q = nwg / NXCD, r = nwg % NXCD, xcd = wgid % NXCD, off = wgid / NXCD; wgid = (xcd < r ? xcd * (q + 1) : r * (q + 1) + (xcd - r) * q) + off; }
        const int nig = WGM * nN, gid = wgid / nig, fm = gid * WGM, gsz = (nM - fm) < WGM ? (nM - fm) : WGM;
        u.pm = fm + ((wgid % nig) % gsz); u.pn = (wgid % nig) / gsz; return true;
    }
};
DI unsigned cvt_pk_bf16(float lo, float hi) { unsigned r; asm volatile("v_cvt_pk_bf16_f32 %0, %1, %2" : "=v"(r) : "v"(lo), "v"(hi)); return r; }

template <class Epi>
DI void gemm_phase(LAS unsigned char* lds, const Gemm g, const StaticOrder& S, const Epi& E) {
    int tid = threadIdx.x; asm volatile("" : "+v"(tid));
    const int wid = __builtin_amdgcn_readfirstlane(tid >> 6), lane = tid & 63, wr = wid >> 2, wc = wid & 3, fr = lane & 15, fq = lane >> 4;
    const int K = g.K, nt = K / BK;
    unsigned voffA[2], voffB[2];
#pragma unroll
    for (int i = 0; i < 2; ++i) { int R, C; stage_rc(tid * 16 + i * 8192, R, C); const int Rb = (R & ~31) + perm32(R & 31);
        voffA[i] = (unsigned)(R * K + C) * 2u; voffB[i] = (unsigned)(Rb * K + C) * 2u; }
    const size_t kstep = (size_t)(BK * 2);
    const size_t hstep = (size_t)HALF * K * 2;
    const size_t tstep = 2 * hstep;
    const unsigned ldsw = (unsigned)wid * 1024u;
    const int aoff = lds_byte(wr * 64 + fr, fq * 8), boff = lds_byte(wc * 32 + fr, fq * 8);
#define PG8_SA(b, h) (((b) * 2 + (h)) * HTB)
#define PG8_SB(b, h) ((4 + (b) * 2 + (h)) * HTB)
#define PG8_STAGE(bufoff, gbase, voff) do { _Pragma("unroll") for (int _i = 0; _i < 2; ++_i) \
        __builtin_amdgcn_global_load_lds((const unsigned*)((const char*)(gbase) + (voff)[_i]), (LAS unsigned*)(lds + (bufoff) + ldsw + _i * 8192), 16, 0, 0); } while (0)
#define PG8_LDA(dst, b, h) do { _Pragma("unroll") for (int m = 0; m < 4; ++m) _Pragma("unroll") for (int k = 0; k < 2; ++k) dst[m][k] = *(const LAS bf16x8*)(lds + PG8_SA(b, h) + aoff + m * 2048 + k * 1024); } while (0)
#define PG8_LDB(dst, b, h) do { _Pragma("unroll") for (int n = 0; n < 2; ++n) _Pragma("unroll") for (int k = 0; k < 2; ++k) dst[n][k] = *(const LAS bf16x8*)(lds + PG8_SB(b, h) + boff + n * 2048 + k * 1024); } while (0)
#define PG8_MMA(ai, bj, At, Bt) do { __builtin_amdgcn_s_setprio(1); _Pragma("unroll") for (int m = 0; m < 4; ++m) _Pragma("unroll") for (int n = 0; n < 2; ++n) _Pragma("unroll") for (int k = 0; k < 2; ++k) \
        acc[ai][bj][m][n] = __builtin_amdgcn_mfma_f32_16x16x32_bf16(Bt[n][k], At[m][k], acc[ai][bj][m][n], 0, 0, 0); __builtin_amdgcn_s_setprio(0); } while (0)
#define PG8_WAIT_V(n) asm volatile("s_waitcnt vmcnt(" #n ")" ::: "memory")
#define PG8_WAIT_L(n) asm volatile("s_waitcnt lgkmcnt(" #n ")" ::: "memory")
#define PG8_BAR __builtin_amdgcn_s_barrier()
#define PG8_SCHED __builtin_amdgcn_sched_barrier(0)
    Unit cur, nxt; int ui = 0;
    if (!S.next(0, cur)) return;
    f32x4 acc[2][2][4][2];
#pragma unroll
    for (int a = 0; a < 2; ++a)
#pragma unroll
        for (int b = 0; b < 2; ++b)
#pragma unroll
            for (int m = 0; m < 4; ++m)
#pragma unroll
                for (int n = 0; n < 2; ++n) acc[a][b][m][n] = (f32x4){0.f, 0.f, 0.f, 0.f};
    bf16x8 At[4][2], B0[2][2], B1[2][2];
    const char* cA = (const char*)g.A + (size_t)cur.pm * tstep; const char* cB = (const char*)g.Bt + (size_t)cur.pn * tstep;
    PG8_STAGE(PG8_SB(0, 0), cB, voffB); PG8_STAGE(PG8_SA(0, 0), cA, voffA); PG8_STAGE(PG8_SB(0, 1), cB + hstep, voffB); PG8_STAGE(PG8_SA(0, 1), cA + hstep, voffA);
    if (wr == 1) PG8_BAR;
    PG8_WAIT_V(4); PG8_BAR;
    PG8_STAGE(PG8_SB(1, 0), cB + kstep, voffB); PG8_STAGE(PG8_SA(1, 0), cA + kstep, voffA); PG8_STAGE(PG8_SB(1, 1), cB + hstep + kstep, voffB);
    PG8_WAIT_V(6); PG8_BAR;
    for (;;) {
        const bool has_next = S.next(ui + 1, nxt);
        const char* nA = has_next ? (const char*)g.A + (size_t)nxt.pm * tstep : cA; const char* nB = has_next ? (const char*)g.Bt + (size_t)nxt.pn * tstep : cB;
        for (int t = 0; t < nt; t += 2) {
            const bool last = (t == nt - 2);
            const char* a1 = cA + (size_t)(t + 1) * kstep;
            const char* a2 = last ? nA : cA + (size_t)(t + 2) * kstep; const char* b2 = last ? nB : cB + (size_t)(t + 2) * kstep;
            const char* a3 = a2 + kstep; const char* b3 = b2 + kstep;
            PG8_LDB(B0, 0, 0); PG8_SCHED; PG8_LDA(At, 0, 0); PG8_STAGE(PG8_SA(1, 1), a1 + hstep, voffA);
            PG8_WAIT_L(8); PG8_BAR; PG8_WAIT_L(0); PG8_MMA(0, 0, At, B0); PG8_BAR; PG8_SCHED;
            PG8_LDB(B1, 0, 1); PG8_STAGE(PG8_SB(0, 0), b2, voffB);
            PG8_BAR; PG8_WAIT_L(0); PG8_MMA(0, 1, At, B1); PG8_BAR;
            PG8_LDA(At, 0, 1); PG8_STAGE(PG8_SA(0, 0), a2, voffA);
            PG8_BAR; PG8_WAIT_L(0); PG8_MMA(1, 0, At, B0); PG8_BAR; PG8_SCHED;
            PG8_STAGE(PG8_SB(0, 1), b2 + hstep, voffB);
            PG8_WAIT_V(6); PG8_BAR; PG8_MMA(1, 1, At, B1); PG8_BAR;
            PG8_LDB(B0, 1, 0); PG8_SCHED; PG8_LDA(At, 1, 0); PG8_STAGE(PG8_SA(0, 1), a2 + hstep, voffA);
            PG8_WAIT_L(8); PG8_BAR; PG8_WAIT_L(0); PG8_MMA(0, 0, At, B0); PG8_BAR; PG8_SCHED;
            PG8_LDB(B1, 1, 1); PG8_STAGE(PG8_SB(1, 0), b3, voffB);
            PG8_BAR; PG8_WAIT_L(0); PG8_MMA(0, 1, At, B1); PG8_BAR;
            PG8_LDA(At, 1, 1); PG8_STAGE(PG8_SA(1, 0), a3, voffA);
            PG8_BAR; PG8_WAIT_L(0); PG8_MMA(1, 0, At, B0); PG8_BAR; PG8_SCHED;
            PG8_STAGE(PG8_SB(1, 1), b3 + hstep, voffB);
            PG8_WAIT_V(6); PG8_BAR; PG8_MMA(1, 1, At, B1); PG8_BAR;
        }
        E(acc, cur, wr, wc, fr, fq);
        if (!has_next) break;
#pragma unroll
        for (int a = 0; a < 2; ++a)
#pragma unroll
            for (int b = 0; b < 2; ++b)
#pragma unroll
                for (int m = 0; m < 4; ++m)
#pragma unroll
                    for (int n = 0; n < 2; ++n) acc[a][b][m][n] = (f32x4){0.f, 0.f, 0.f, 0.f};
        cur = nxt; cA = nA; cB = nB; ++ui;
    }
    PG8_WAIT_V(0);
    if (wr == 0) PG8_BAR;
    PG8_BAR;
#undef PG8_SA
#undef PG8_SB
#undef PG8_STAGE
#undef PG8_LDA
#undef PG8_LDB
#undef PG8_MMA
#undef PG8_WAIT_V
#undef PG8_WAIT_L
#undef PG8_BAR
#undef PG8_SCHED
}

typedef f32x4 Acc[2][2][4][2];

DI void row_scales(const float* ssp, int row0, int fq, float (&rs)[2][4]) {
#pragma unroll
    for (int ai = 0; ai < 2; ++ai)
#pragma unroll
        for (int m = 0; m < 4; ++m) {
            const f32x4 p = *(const f32x4*)(ssp + (size_t)(row0 + ai * HALF + m * 16) * 16 + 4 * fq);
            float s = (p.x + p.y) + (p.z + p.w); s += __shfl_xor(s, 16); s += __shfl_xor(s, 32);
            rs[ai][m] = rsqrtf(s * (1.0f / 1024.0f) + EPS);
        }
}

DI float row_scale1(const float* ssp, int row, int fq) {
    const f32x4 p = *(const f32x4*)(ssp + (size_t)row * 16 + 4 * fq);
    float s = (p.x + p.y) + (p.z + p.w); s += __shfl_xor(s, 16); s += __shfl_xor(s, 32);
    return rsqrtf(s * (1.0f / 1024.0f) + EPS);
}
template <int ACT> DI void store_plain(Acc& acc, const float* ssp, bf16_t* O, int ldc, int row0, int col0, int fq) {
#pragma unroll
    for (int ai = 0; ai < 2; ++ai)
#pragma unroll
        for (int m = 0; m < 4; ++m) { int r0v = row0; asm volatile("" : "+v"(r0v)); const int row = r0v + ai * HALF + m * 16; bf16_t* rowp = O + (size_t)row * ldc + col0; const float s = row_scale1(ssp, row, fq);
#pragma unroll
            for (int bj = 0; bj < 2; ++bj) { f32x4 v0 = acc[ai][bj][m][0] * s, v1 = acc[ai][bj][m][1] * s;
                if (ACT == 1) {
#pragma unroll
                    for (int j = 0; j < 4; ++j) { v0[j] = gelu_tanh(v0[j]); v1[j] = gelu_tanh(v1[j]); } }
                if (ACT == 2) {
#pragma unroll
                    for (int j = 0; j < 4; ++j) { v0[j] = sigmoidf_(v0[j]); v1[j] = sigmoidf_(v1[j]); } }
                u32x4 w; w.x = cvt_pk_bf16(v0[0], v0[1]); w.y = cvt_pk_bf16(v0[2], v0[3]); w.z = cvt_pk_bf16(v1[0], v1[1]); w.w = cvt_pk_bf16(v1[2], v1[3]);
                *(u32x4*)(rowp + bj * HALF) = w; }
            asm volatile("" ::: "memory"); }
}
struct EpiIn {
    const float* ssp; bf16_t *XR, *GG, *SGR, *SGA, *Q, *Kc, *V; const float *qg, *kg, *cosT, *sinT; LAS float* tab;
    DI void operator()(Acc& acc, const Unit& u, int wr, int wc, int fr, int fq) const {
        const int row0 = u.pm * BM + wr * 64 + fr, pn = u.pn;
        if (pn < 16 || pn >= 28) {
            const int cw = wc * 32 + 8 * fq;
            if (pn < 4) store_plain<0>(acc, ssp, XR, 1024, row0, pn * 256 + cw, fq);
            else if (pn < 8) store_plain<1>(acc, ssp, GG, 1024, row0, (pn - 4) * 256 + cw, fq);
            else if (pn < 12) store_plain<2>(acc, ssp, SGR, 1024, row0, (pn - 8) * 256 + cw, fq);
            else if (pn < 16) store_plain<2>(acc, ssp, SGA, 1024, row0, (pn - 12) * 256 + cw, fq);
            else store_plain<0>(acc, ssp, V, 1536, row0, (pn - 28) * 256 + cw, fq);
        } else {
            const bool isq = pn < 22; const int head0 = 2 * (pn - (isq ? 16 : 22)); bf16_t* O = isq ? Q : Kc; const float* gw = isq ? qg : kg; const float osc = isq ? 0.08838834764831845f : 1.0f;
            const int d0 = 16 * wc + 4 * fq;
#pragma unroll
            for (int ai = 0; ai < 2; ++ai)
#pragma unroll
                for (int m = 0; m < 4; ++m) { int r0v = row0; asm volatile("" : "+v"(r0v)); const float s = row_scale1(ssp, r0v + ai * HALF + m * 16, fq); const int rl = (r0v & 255) + ai * HALF + m * 16;
#pragma unroll
                    for (int bj = 0; bj < 2; ++bj) { const f32x4 a = acc[ai][bj][m][0], b = acc[ai][bj][m][1];
                        float q = (a[0] * a[0] + a[1] * a[1]) + (a[2] * a[2] + a[3] * a[3]) + (b[0] * b[0] + b[1] * b[1]) + (b[2] * b[2] + b[3] * b[3]);
                        q *= s * s; q += __shfl_xor(q, 16); q += __shfl_xor(q, 32);
                        if (fq == 0) tab[(rl * 2 + bj) * 4 + wc] = q; }
                    asm volatile("" ::: "memory"); }
            asm volatile("s_waitcnt lgkmcnt(0)" ::: "memory"); __builtin_amdgcn_s_barrier(); asm volatile("" ::: "memory");
            const f32x4 g1a = *(const f32x4*)(gw + head0 * 128 + d0), g2a = *(const f32x4*)(gw + head0 * 128 + 64 + d0);
            const f32x4 g1b = *(const f32x4*)(gw + head0 * 128 + 128 + d0), g2b = *(const f32x4*)(gw + head0 * 128 + 192 + d0);
#pragma unroll
            for (int ai = 0; ai < 2; ++ai)
#pragma unroll
                for (int m = 0; m < 4; ++m) { int r0v = row0; asm volatile("" : "+v"(r0v)); const int rl = (r0v & 255) + ai * HALF + m * 16; const size_t row = (size_t)(r0v + ai * HALF + m * 16);
                    const f32x4 cs = *(const f32x4*)(cosT + row * 64 + d0), sn = *(const f32x4*)(sinT + row * 64 + d0); const float s = row_scale1(ssp, (int)row, fq) * osc;
#pragma unroll
                    for (int bj = 0; bj < 2; ++bj) { const f32x4 pp = *(const LAS f32x4*)(tab + (rl * 2 + bj) * 4);
                        const float inv = rsqrtf(((pp.x + pp.y) + (pp.z + pp.w)) * (1.0f / 128.0f) + EPS) * s;
                        const f32x4 x1 = acc[ai][bj][m][0] * inv * (bj ? g1b : g1a), x2 = acc[ai][bj][m][1] * inv * (bj ? g2b : g2a);
                        const f32x4 o1 = x1 * cs - x2 * sn, o2 = x2 * cs + x1 * sn;
                        u32x2 w1, w2; w1.x = cvt_pk_bf16(o1[0], o1[1]); w1.y = cvt_pk_bf16(o1[2], o1[3]); w2.x = cvt_pk_bf16(o2[0], o2[1]); w2.y = cvt_pk_bf16(o2[2], o2[3]);
                        bf16_t* p = O + row * AW + (head0 + bj) * 128 + d0; *(u32x2*)p = w1; *(u32x2*)(p + 64) = w2; }
                    asm volatile("" ::: "memory"); }
        }
    }
};
struct EpiProj1 {
    const bf16_t* SG; float* TMP;
    DI void operator()(Acc& acc, const Unit& u, int wr, int wc, int fr, int fq) const {
        const int row0 = u.pm * BM + wr * 64 + fr, col0 = u.pn * BM + wc * 32 + 8 * fq;
#pragma unroll
        for (int ai = 0; ai < 2; ++ai)
#pragma unroll
            for (int m = 0; m < 4; ++m) { int r0v = row0; asm volatile("" : "+v"(r0v)); const size_t off = (size_t)(r0v + ai * HALF + m * 16) * DM + col0;
#pragma unroll
                for (int bj = 0; bj < 2; ++bj) { const u32x4 sg = *(const u32x4*)(SG + off + bj * HALF);
                    f32x4 v0 = acc[ai][bj][m][0], v1 = acc[ai][bj][m][1];
                    v0[0] *= bflo(sg.x); v0[1] *= bfhi(sg.x); v0[2] *= bflo(sg.y); v0[3] *= bfhi(sg.y); v1[0] *= bflo(sg.z); v1[1] *= bfhi(sg.z); v1[2] *= bflo(sg.w); v1[3] *= bfhi(sg.w);
                    *(f32x4*)(TMP + off + bj * HALF) = v0; *(f32x4*)(TMP + off + bj * HALF + 4) = v1; }
                asm volatile("" ::: "memory"); }
    }
};
struct EpiProj2 {
    const bf16_t* SG; const float* TMP; bf16_t* MG;
    DI void operator()(Acc& acc, const Unit& u, int wr, int wc, int fr, int fq) const {
        const int row0 = u.pm * BM + wr * 64 + fr, col0 = u.pn * BM + wc * 32 + 8 * fq;
#pragma unroll
        for (int ai = 0; ai < 2; ++ai)
#pragma unroll
            for (int m = 0; m < 4; ++m) { int r0v = row0; asm volatile("" : "+v"(r0v)); const size_t off = (size_t)(r0v + ai * HALF + m * 16) * DM + col0;
#pragma unroll
                for (int bj = 0; bj < 2; ++bj) { const u32x4 sg = *(const u32x4*)(SG + off + bj * HALF);
                    const f32x4 t0 = *(const f32x4*)(TMP + off + bj * HALF), t1 = *(const f32x4*)(TMP + off + bj * HALF + 4);
                    f32x4 v0 = acc[ai][bj][m][0], v1 = acc[ai][bj][m][1];
                    v0[0] = t0[0] + v0[0] * bflo(sg.x); v0[1] = t0[1] + v0[1] * bfhi(sg.x); v0[2] = t0[2] + v0[2] * bflo(sg.y); v0[3] = t0[3] + v0[3] * bfhi(sg.y);
                    v1[0] = t1[0] + v1[0] * bflo(sg.z); v1[1] = t1[1] + v1[1] * bfhi(sg.z); v1[2] = t1[2] + v1[2] * bflo(sg.w); v1[3] = t1[3] + v1[3] * bfhi(sg.w);
                    u32x4 w; w.x = cvt_pk_bf16(v0[0], v0[1]); w.y = cvt_pk_bf16(v0[2], v0[3]); w.z = cvt_pk_bf16(v1[0], v1[1]); w.w = cvt_pk_bf16(v1[2], v1[3]);
                    *(u32x4*)(MG + off + bj * HALF) = w; }
                asm volatile("" ::: "memory"); }
    }
};
struct EpiResid {
    const float* xin; float* xout; bf16_t* XB; float* ssp;
    DI void operator()(Acc& acc, const Unit& u, int wr, int wc, int fr, int fq) const {
        const int row0 = u.pm * BM + wr * 64 + fr, col0 = u.pn * BM + wc * 32 + 8 * fq;
#pragma unroll
        for (int ai = 0; ai < 2; ++ai)
#pragma unroll
            for (int m = 0; m < 4; ++m) { int r0v = row0; asm volatile("" : "+v"(r0v)); const int row = r0v + ai * HALF + m * 16; const size_t off = (size_t)row * DM + col0; float q = 0.f;
#pragma unroll
                for (int bj = 0; bj < 2; ++bj) {
                    const f32x4 a0 = *(const f32x4*)(xin + off + bj * HALF), a1 = *(const f32x4*)(xin + off + bj * HALF + 4);
                    const f32x4 o0 = a0 + acc[ai][bj][m][0], o1 = a1 + acc[ai][bj][m][1];
                    *(f32x4*)(xout + off + bj * HALF) = o0; *(f32x4*)(xout + off + bj * HALF + 4) = o1;
                    q += (o0[0] * o0[0] + o0[1] * o0[1]) + (o0[2] * o0[2] + o0[3] * o0[3]) + (o1[0] * o1[0] + o1[1] * o1[1]) + (o1[2] * o1[2] + o1[3] * o1[3]);
                    u32x4 w; w.x = cvt_pk_bf16(o0[0], o0[1]); w.y = cvt_pk_bf16(o0[2], o0[3]); w.z = cvt_pk_bf16(o1[0], o1[1]); w.w = cvt_pk_bf16(o1[2], o1[3]);
                    *(u32x4*)(XB + off + bj * HALF) = w; }
                q += __shfl_xor(q, 16); q += __shfl_xor(q, 32);
                if (fq == 0) ssp[(size_t)row * 16 + u.pn * 4 + wc] = q;
                asm volatile("" ::: "memory"); }
    }
};
struct EpiUp {
    const float* ssp; bf16_t* U;
    DI void operator()(Acc& acc, const Unit& u, int wr, int wc, int fr, int fq) const {
        const int row0 = u.pm * BM + wr * 64 + fr, col0 = u.pn * BM + wc * 32 + 8 * fq;
#pragma unroll
        for (int ai = 0; ai < 2; ++ai)
#pragma unroll
            for (int m = 0; m < 4; ++m) { int r0v = row0; asm volatile("" : "+v"(r0v)); const int row = r0v + ai * HALF + m * 16; bf16_t* rowp = U + (size_t)row * NUP + col0; const float s = row_scale1(ssp, row, fq);
#pragma unroll
                for (int bj = 0; bj < 2; ++bj) { const f32x4 v0 = acc[ai][bj][m][0] * s, v1 = acc[ai][bj][m][1] * s;
                    u32x4 w; w.x = cvt_pk_bf16(v0[0], v0[1]); w.y = cvt_pk_bf16(v0[2], v0[3]); w.z = cvt_pk_bf16(v1[0], v1[1]); w.w = cvt_pk_bf16(v1[2], v1[3]);
                    *(u32x4*)(rowp + bj * HALF) = w; }
                asm volatile("" ::: "memory"); }
    }
};
}

#define XB_TMO      128
#define XB_XCNT(j)  (256  + 64 * (j))
#define XB_XSUB(j)  (1280 + 64 * (j))
#define XB_XGEN(j)  (2304 + 64 * (j))
#define XB_TOP      3328
#define XB_TOPGEN   3392
#define XB_SPIN_CAP (1u << 22)
DI unsigned xb_ld(unsigned* p)              { return __hip_atomic_load(p, __ATOMIC_RELAXED, __HIP_MEMORY_SCOPE_AGENT); }
DI unsigned xb_add(unsigned* p, unsigned v) { return __hip_atomic_fetch_add(p, v, __ATOMIC_RELAXED, __HIP_MEMORY_SCOPE_AGENT); }
DI unsigned xb_xcc_id() { return (unsigned)__builtin_amdgcn_s_getreg((3 << 11) | 20) & 0xFu; }
#define XB_SPIN(cond, bar) do { unsigned _sp = 0; while (cond) { __builtin_amdgcn_s_sleep(1); \
    if ((++_sp & 255u) == 0u) { if (xb_ld(&(bar)[XB_TMO])) break; if (_sp > XB_SPIN_CAP) { atomicAdd(&(bar)[XB_TMO], 1u); break; } } } } while (0)
struct XcdBarrier { unsigned* bar; unsigned x; volatile LAS unsigned* st; };
DI XcdBarrier xcd_barrier_post(unsigned* bar, volatile LAS unsigned* st) {
    XcdBarrier b; b.bar = bar; b.x = xb_xcc_id(); b.st = st;
    if (threadIdx.x == 0) (void)xb_add(&bar[XB_XCNT(b.x)], 1u);
    return b;
}
DI void xcd_barrier_complete(unsigned* bar, unsigned x, unsigned& nloc, unsigned& nx) {
    const unsigned G = gridDim.x * gridDim.y * gridDim.z;
    unsigned sum, cnt, mine, sp = 0u;
    for (;;) {
        sum = 0u; cnt = 0u; mine = 0u;
#pragma unroll
        for (unsigned j = 0; j < 16; ++j) { const unsigned c = xb_ld(&bar[XB_XCNT(j)]); sum += c; cnt += (c > 0u) ? 1u : 0u; mine = (j == x) ? c : mine; }
        if (sum == G) break;
        __builtin_amdgcn_s_sleep(1);
        if ((++sp & 255u) == 0u) { if (xb_ld(&bar[XB_TMO])) break; if (sp > XB_SPIN_CAP) { atomicAdd(&bar[XB_TMO], 1u); break; } }
    }
    nloc = mine > 0u ? mine : 1u; nx = cnt > 0u ? cnt : 1u;
}
DI void xcd_barrier(const XcdBarrier& b) {
    asm volatile("s_waitcnt vmcnt(0)" ::: "memory");
    __syncthreads();
    if (threadIdx.x == 0) {
        unsigned* bar = b.bar;
        __builtin_amdgcn_s_waitcnt(0);
        unsigned nloc = b.st[0], nx = b.st[1];
        if (nloc == 0u) { xcd_barrier_complete(bar, b.x, nloc, nx); b.st[0] = nloc; b.st[1] = nx; }
        const unsigned old = xb_add(&bar[XB_XSUB(b.x)], 1u);
        const unsigned gen = old / nloc;
        if (old + 1u == (gen + 1u) * nloc) {
            __builtin_amdgcn_fence(__ATOMIC_RELEASE, "agent");
            asm volatile("s_waitcnt vmcnt(0)" ::: "memory");
            const unsigned og = xb_add(&bar[XB_TOP], 1u);
            const unsigned tg = og / nx;
            if (og + 1u == (tg + 1u) * nx) xb_add(&bar[XB_TOPGEN], 1u);
            else XB_SPIN(xb_ld(&bar[XB_TOPGEN]) == tg, bar);
            __builtin_amdgcn_fence(__ATOMIC_ACQUIRE, "agent");
            xb_add(&bar[XB_XGEN(b.x)], 1u);
            asm volatile("s_waitcnt vmcnt(0)" ::: "memory");
        } else {
            XB_SPIN(xb_ld(&bar[XB_XGEN(b.x)]) == gen, bar);
            __builtin_amdgcn_fence(__ATOMIC_ACQUIRE, "agent");
            asm volatile("s_waitcnt vmcnt(0)" ::: "memory");
        }
    }
    __syncthreads();
}

struct Args { const void* in[21]; float* out; unsigned char* ws; int ph_lo, ph_hi, coop, pad; };

DI int qkperm(int d) { return 32 * ((d >> 4) & 3) + 8 * ((d >> 2) & 3) + 4 * (d >> 6) + (d & 3); }
DI int map_in(int n) {
    if (n < 2048) return n;
    if (n < 3584) { const int e = n - 2048; return 4096 + (e & ~127) + qkperm(e & 127); }
    if (n < 5120) { const int e = n - 3584; return 5632 + (e & ~127) + qkperm(e & 127); }
    if (n < 6656) return 7168 + (n - 5120);
    return 2048 + (n - 6656);
}
DI void transpose_item(const float* W, int K, int N, bf16_t* WT, const float* gk, int mapkind, LAS float* scr, int item, int lane) {
    const int nblk = N / 32, kb = item / nblk, nb = item % nblk, k0 = 64 * kb, n0 = 32 * nb;
#pragma unroll 8
    for (int i = 0; i < 32; ++i) { const int kk = 2 * i + (lane >> 5); float w = W[(size_t)(k0 + kk) * N + n0 + (lane & 31)]; if (gk) w *= gk[k0 + kk]; scr[kk * 33 + (lane & 31)] = w; }
    LDS_WAIT(); asm volatile("" ::: "memory");
    const int c = lane & 7;
#pragma unroll
    for (int j = 0; j < 4; ++j) { const int n = (lane >> 3) + 8 * j; const LAS float* s = scr + (8 * c) * 33 + n;
        u32x4 o; o.x = pk2(s[0 * 33], s[1 * 33]); o.y = pk2(s[2 * 33], s[3 * 33]); o.z = pk2(s[4 * 33], s[5 * 33]); o.w = pk2(s[6 * 33], s[7 * 33]);
        const int dst = mapkind ? map_in(n0 + n) : (n0 + n);
        *(u32x4*)(WT + (size_t)dst * K + k0 + 8 * c) = o; }
    LDS_WAIT(); asm volatile("" ::: "memory");
}
DI void convert_weights(const Args& a, int l, int mask, LAS unsigned char* lds, int gw, int NGW, int wave, int lane) {
    LAS float* scr = (LAS float*)(lds + wave * 8448);
    unsigned char* ws = a.ws;
    constexpr int I_IN = 16 * 272, I_LRU = 8 * 8, I_DN = 48 * 32, I_PR = 16 * 32, I_PA = 8 * 32, I_WO = 16 * 32, I_UP = 16 * 192;
    const int total = ((mask & 1) ? I_IN : 0) + ((mask & 2) ? 2 * I_LRU : 0) + ((mask & 4) ? I_DN : 0) + ((mask & 8) ? (I_PR + I_PA + I_WO + I_UP) : 0);
    for (int it = gw; it < total; it += NGW) {
        int r = it;
        if (mask & 1) { if (r < I_IN) { transpose_item((const float*)a.in[3] + (size_t)l * DM * NIN, DM, NIN, (bf16_t*)(ws + WS_W1T), (const float*)a.in[2] + l * DM, 1, scr, r, lane); continue; } r -= I_IN; }
        if (mask & 2) {
            if (r < I_LRU) { const int blk = r >> 3; transpose_item((const float*)a.in[6] + (size_t)l * 131072 + blk * 16384, 128, 128, (bf16_t*)(ws + WS_WAT) + blk * 16384, nullptr, 0, scr, r & 7, lane); continue; } r -= I_LRU;
            if (r < I_LRU) { const int blk = r >> 3; transpose_item((const float*)a.in[8] + (size_t)l * 131072 + blk * 16384, 128, 128, (bf16_t*)(ws + WS_WXT) + blk * 16384, nullptr, 0, scr, r & 7, lane); continue; } r -= I_LRU; }
        if (mask & 4) { if (r < I_DN) { transpose_item((const float*)a.in[20] + (size_t)l * DFF * DM, DFF, DM, (bf16_t*)(ws + WS_WDT), nullptr, 0, scr, r, lane); continue; } r -= I_DN; }
        if (mask & 8) {
            if (r < I_PR) { transpose_item((const float*)a.in[13] + (size_t)l * DM * DM, DM, DM, (bf16_t*)(ws + WS_PRT), nullptr, 0, scr, r, lane); continue; } r -= I_PR;
            if (r < I_PA) { transpose_item((const float*)a.in[14] + (size_t)l * 512 * DM, 512, DM, (bf16_t*)(ws + WS_PAT), nullptr, 0, scr, r, lane); continue; } r -= I_PA;
            if (r < I_WO) { transpose_item((const float*)a.in[15] + (size_t)l * DM * DM, DM, DM, (bf16_t*)(ws + WS_WOT), nullptr, 0, scr, r, lane); continue; } r -= I_WO;
            transpose_item((const float*)a.in[17] + (size_t)l * DM * NUP, DM, NUP, (bf16_t*)(ws + WS_WUT), (const float*)a.in[16] + l * DM, 0, scr, r, lane); }
    }
}

DI void p0_rows(const Args& a, int gw, int NGW, int lane) {
    const float* x = (const float*)a.in[0]; bf16_t* XB = (bf16_t*)(a.ws + WS_XB); float* ssp = (float*)(a.ws + WS_SSP);
    for (int m = gw; m < T; m += NGW) {
        const f32x4* xr = (const f32x4*)(x + (size_t)m * DM) + lane; f32x4 v[4]; float s = 0.f;
#pragma unroll
        for (int j = 0; j < 4; ++j) { v[j] = xr[64 * j]; s += (v[j].x * v[j].x + v[j].y * v[j].y) + (v[j].z * v[j].z + v[j].w * v[j].w); }
#pragma unroll
        for (int o = 1; o < 64; o <<= 1) s += __shfl_xor(s, o);
        u32x2* o8 = (u32x2*)(XB + (size_t)m * DM) + lane;
#pragma unroll
        for (int j = 0; j < 4; ++j) { u32x2 w; w.x = pk2(v[j].x, v[j].y); w.y = pk2(v[j].z, v[j].w); o8[64 * j] = w; }
        if (lane < 16) ssp[(size_t)m * 16 + lane] = (lane == 0) ? s : 0.f;
    }
}
DI void p0_rope(const Args& a, int gtid, int nthr) {
    const int* pos = (const int*)a.in[1]; float* cosT = (float*)(a.ws + WS_COS); float* sinT = (float*)(a.ws + WS_SIN);
    for (int i = gtid; i < T * 64; i += nthr) {
        const int t = i >> 6, f = i & 63;
        const float inv = exp2f(-(float)f * (13.287712379549449f / 64.0f));
        const float ang = (float)pos[t] * inv;
        const double ad = (double)ang; const double kk = __builtin_rint(ad * 0.15915494309189535); const float r = (float)(ad - kk * 6.283185307179586);
        cosT[i] = __cosf(r); sinT[i] = __sinf(r);
    }
}

#define MFMA32(a, b, c) __builtin_amdgcn_mfma_f32_32x32x16_bf16((a), (b), (c), 0, 0, 0)
DI void lru_item(const Args& a, int l, LAS unsigned char* lds, int item, int tid, int wave, int lane) {
    unsigned char* ws = a.ws;
    const int b = item >> 8, n = (item >> 5) & 7, ck = item & 31;
    const int t0 = b * SEQ + ck * 64, c0 = n * 128;
    const bf16_t* XR = (const bf16_t*)(ws + WS_AR + AR_XR);
    LAS unsigned char* XCb = lds;
    LAS float* XCF = (LAS float*)(lds + 17408);
    LAS float* AA = (LAS float*)(lds + 17408 + 32768);
    {
        const int cg8 = tid & 15, tr = tid >> 4, c = c0 + 8 * cg8;
        const float* cw = (const float*)a.in[4] + (size_t)l * 4 * DM + c; const float* cb = (const float*)a.in[5] + (size_t)l * DM + c;
        float w[4][8], bb[8];
#pragma unroll
        for (int i = 0; i < 4; ++i) { const f32x4 w0 = *(const f32x4*)(cw + i * DM), w1 = *(const f32x4*)(cw + i * DM + 4);
#pragma unroll
            for (int e = 0; e < 4; ++e) { w[i][e] = w0[e]; w[i][4 + e] = w1[e]; } }
        { const f32x4 b0 = *(const f32x4*)cb, b1 = *(const f32x4*)(cb + 4);
#pragma unroll
          for (int e = 0; e < 4; ++e) { bb[e] = b0[e]; bb[4 + e] = b1[e]; } }
#pragma unroll
        for (int j = 0; j < 2; ++j) { const int tl = tr + 32 * j, tp = ck * 64 + tl; float o[8];
#pragma unroll
            for (int e = 0; e < 8; ++e) o[e] = bb[e];
#pragma unroll
            for (int i = 0; i < 4; ++i) { const int p = tp - 3 + i;
                if (p >= 0) { const u32x4 v = *(const u32x4*)(XR + (size_t)(b * SEQ + p) * DM + c);
                    o[0] += w[i][0] * bflo(v.x); o[1] += w[i][1] * bfhi(v.x); o[2] += w[i][2] * bflo(v.y); o[3] += w[i][3] * bfhi(v.y);
                    o[4] += w[i][4] * bflo(v.z); o[5] += w[i][5] * bfhi(v.z); o[6] += w[i][6] * bflo(v.w); o[7] += w[i][7] * bfhi(v.w); } }
            *(LAS f32x4*)(XCF + tl * 128 + 8 * cg8) = (f32x4){o[0], o[1], o[2], o[3]}; *(LAS f32x4*)(XCF + tl * 128 + 8 * cg8 + 4) = (f32x4){o[4], o[5], o[6], o[7]};
            u32x4 pw; pw.x = pk2(o[0], o[1]); pw.y = pk2(o[2], o[3]); pw.z = pk2(o[4], o[5]); pw.w = pk2(o[6], o[7]);
            *(LAS u32x4*)(XCb + tl * 272 + 16 * cg8) = pw; }
    }
    __syncthreads();
    {
        const int r = lane & 31, h = lane >> 5;
        const bf16_t* wrow = (r < 16) ? (const bf16_t*)(ws + WS_WAT) + n * 16384 + (16 * wave + r) * 128 : (const bf16_t*)(ws + WS_WXT) + n * 16384 + (16 * wave + r - 16) * 128;
        bf16x8 bfr[8];
#pragma unroll
        for (int ks = 0; ks < 8; ++ks) bfr[ks] = *(const bf16x8*)(wrow + 16 * ks + 8 * h);
        const int cl = 16 * wave + (r & 15); const bool isI = r >= 16;
        const float bias = isI ? ((const float*)a.in[9])[(size_t)l * DM + c0 + cl] : ((const float*)a.in[7])[(size_t)l * DM + c0 + cl];
        const float lam = ((const float*)a.in[10])[(size_t)l * DM + c0 + cl];
        const float sp8 = 8.0f * log1pf(expf(-lam));
#pragma unroll
        for (int rt = 0; rt < 2; ++rt) {
            f32x16 acc;
#pragma unroll
            for (int i = 0; i < 16; ++i) acc[i] = 0.f;
#pragma unroll
            for (int ks = 0; ks < 8; ++ks) { const bf16x8 af = *(const LAS bf16x8*)(XCb + (32 * rt + r) * 272 + (16 * ks + 8 * h) * 2); acc = MFMA32(af, bfr[ks], acc); }
#pragma unroll
            for (int i = 0; i < 16; ++i) { const int tl = 32 * rt + (i & 3) + 8 * (i >> 2) + 4 * h;
                const float gte = sigmoidf_(acc[i] + bias); const float oth = __shfl_xor(gte, 16);
                const float rg = isI ? oth : gte, ig = isI ? gte : oth;
                const float la = -sp8 * rg;
                if (!isI) AA[tl * 128 + cl] = expf(la);
                else { const float mult = sqrtf(-expm1f(2.0f * la)); const float xv = XCF[tl * 128 + cl]; XCF[tl * 128 + cl] = mult * (ig * xv); } }
        }
    }
    __syncthreads();
    if (wave < 4) {
        const int cl = 32 * wave + (lane & 31), sg = lane >> 5; const int tb = 32 * sg;
        float A = 1.f, H = 0.f;
#pragma unroll 8
        for (int s = 0; s < 32; ++s) { const float av = AA[(tb + s) * 128 + cl], uv = XCF[(tb + s) * 128 + cl]; H = av * H + uv; A *= av; }
        const float A0 = __shfl(A, lane & 31), H0 = __shfl(H, lane & 31);
        float hh = sg ? H0 : 0.f, Ac = sg ? A0 : 1.f;
        unsigned* HL = (unsigned*)(ws + WS_AR + AR_HL) + (size_t)(t0 + tb) * DM + c0 + cl;
#pragma unroll 8
        for (int s = 0; s < 32; ++s) { const float av = AA[(tb + s) * 128 + cl], uv = XCF[(tb + s) * 128 + cl]; hh = av * hh + uv; Ac *= av; HL[(size_t)s * DM] = pkh2(hh, Ac); }
        if (sg) { ((float*)(ws + WS_AGGA))[(size_t)(b * 32 + ck) * DM + c0 + cl] = Ac; ((float*)(ws + WS_AGGH))[(size_t)(b * 32 + ck) * DM + c0 + cl] = hh; }
    }
    __syncthreads();
}

DI bf16x8 pack8(const f32x16& x, int s) {
    u32x4 p; p.x = pk2(x[8 * s], x[8 * s + 1]); p.y = pk2(x[8 * s + 2], x[8 * s + 3]); p.z = pk2(x[8 * s + 4], x[8 * s + 5]); p.w = pk2(x[8 * s + 6], x[8 * s + 7]);
    return __builtin_bit_cast(bf16x8, p);
}
DI void attn_item(unsigned char* ws, int it, int lane) {
    const bf16_t* Q = (const bf16_t*)(ws + WS_AR + AR_Q); const bf16_t* Kp = (const bf16_t*)(ws + WS_AR + AR_K); const bf16_t* V = (const bf16_t*)(ws + WS_AR + AR_V);
    bf16_t* OG = (bf16_t*)(ws + WS_AR + AR_OG); float* LSE = (float*)(ws + WS_LSE);
    const int b = it / 768, r1 = it % 768, hd = r1 >> 6, qi = r1 & 63;
    const int sh = 2 * (hd >> 2), tps = 64 >> sh;
    const int rstream = qi / tps, m0 = 32 * (qi % tps);
    const int r = lane & 31, h = lane >> 5;
    const size_t qtok = (size_t)b * SEQ + ((size_t)(m0 + r) << sh) + rstream;
    const bf16_t* qrow = Q + qtok * AW + hd * 128 + 8 * h;
    bf16x8 qf[8];
#pragma unroll
    for (int ks = 0; ks < 8; ++ks) qf[ks] = *(const bf16x8*)(qrow + 16 * ks);
    bf16x8 idf[2];
#pragma unroll
    for (int e = 0; e < 2; ++e)
#pragma unroll
        for (int j = 0; j < 8; ++j) idf[e][j] = (16 * e + 8 * h + j == r) ? (short)0x3F80 : (short)0;
    f32x16 O[4];
#pragma unroll
    for (int dt = 0; dt < 4; ++dt)
#pragma unroll
        for (int i = 0; i < 16; ++i) O[dt][i] = 0.f;
    float mrun = -1e30f, lpart = 0.f;
    constexpr float L2E = 1.4426950408889634f;
    for (int kt = 0; kt < 5; ++kt) {
        const int kb = m0 - 128 + 32 * kt;
        if (kb < 0) continue;
        const size_t ktok = (size_t)b * SEQ + ((size_t)(kb + r) << sh) + rstream;
        const bf16_t* krow = Kp + ktok * AW + hd * 128 + 8 * h; const bf16_t* vrow = V + ktok * AW + hd * 128 + 8 * h;
        bf16x8 kf[8], vf[8];
#pragma unroll
        for (int ks = 0; ks < 8; ++ks) kf[ks] = *(const bf16x8*)(krow + 16 * ks);
#pragma unroll
        for (int ks = 0; ks < 8; ++ks) vf[ks] = *(const bf16x8*)(vrow + 16 * ks);
        f32x16 Sx;
#pragma unroll
        for (int i = 0; i < 16; ++i) Sx[i] = 0.f;
#pragma unroll
        for (int ks = 0; ks < 8; ++ks) Sx = MFMA32(kf[ks], qf[ks], Sx);
        float mx = -1e30f;
#pragma unroll
        for (int i = 0; i < 16; ++i) { const int ki = (i & 3) + 8 * (i >> 2) + 4 * h;
            if ((kt == 0 && ki < r) || (kt == 4 && ki > r)) Sx[i] = -1e30f;
            mx = fmaxf(mx, Sx[i]); }
        mx = fmaxf(mx, __shfl_xor(mx, 32));
        const float mnew = fmaxf(mrun, mx), alpha = exp2f((mrun - mnew) * L2E);
        float ps = 0.f;
#pragma unroll
        for (int i = 0; i < 16; ++i) { Sx[i] = exp2f((Sx[i] - mnew) * L2E); ps += Sx[i]; }
        lpart = lpart * alpha + ps; mrun = mnew;
        const bf16x8 pf0 = pack8(Sx, 0), pf1 = pack8(Sx, 1);
#pragma unroll
        for (int dt = 0; dt < 4; ++dt) {
            f32x16 X;
#pragma unroll
            for (int i = 0; i < 16; ++i) X[i] = 0.f;
            X = MFMA32(vf[2 * dt], idf[0], X); X = MFMA32(vf[2 * dt + 1], idf[1], X);
            const bf16x8 xf0 = pack8(X, 0), xf1 = pack8(X, 1);
#pragma unroll
            for (int i = 0; i < 16; ++i) O[dt][i] *= alpha;
            O[dt] = MFMA32(xf0, pf0, O[dt]); O[dt] = MFMA32(xf1, pf1, O[dt]);
        }
    }
    const float ltot = lpart + __shfl_xor(lpart, 32), inv = 1.0f / ltot;
    bf16_t* orow = OG + qtok * AW + hd * 128 + 4 * h;
#pragma unroll
    for (int dt = 0; dt < 4; ++dt)
#pragma unroll
        for (int gq = 0; gq < 4; ++gq) { u32x2 w; w.x = pk2(O[dt][4 * gq] * inv, O[dt][4 * gq + 1] * inv); w.y = pk2(O[dt][4 * gq + 2] * inv, O[dt][4 * gq + 3] * inv);
            *(u32x2*)(orow + 32 * dt + 8 * gq) = w; }
    if (h == 0) LSE[qtok * 12 + hd] = mrun + logf(ltot);
}

DI void b2_fix(const Args& a, int tid) {
    unsigned char* ws = a.ws;
    const float* AGA = (const float*)(ws + WS_AGGA); const float* AGH = (const float*)(ws + WS_AGGH);
    const unsigned* HL = (const unsigned*)(ws + WS_AR + AR_HL); const bf16_t* GG = (const bf16_t*)(ws + WS_AR + AR_GG); bf16_t* YR = (bf16_t*)(ws + WS_AR + AR_YR);
    for (int it = blockIdx.x; it < 256; it += gridDim.x) {
        const int b = it >> 5, ck = it & 31, c = 4 * (tid & 255), th = tid >> 8;
        f32x4 carry = {0.f, 0.f, 0.f, 0.f};
        for (int j = 0; j < ck; ++j) { const f32x4 A = *(const f32x4*)(AGA + (size_t)(b * 32 + j) * DM + c), H = *(const f32x4*)(AGH + (size_t)(b * 32 + j) * DM + c); carry = A * carry + H; }
        const size_t tb = (size_t)b * SEQ + ck * 64 + 32 * th;
#pragma unroll 4
        for (int s = 0; s < 32; ++s) { const size_t off = (tb + s) * DM + c;
            const u32x4 hl = *(const u32x4*)(HL + off); const u32x2 gg = *(const u32x2*)(GG + off);
            const float y0 = (hlo(hl.x) + hhi(hl.x) * carry[0]) * bflo(gg.x), y1 = (hlo(hl.y) + hhi(hl.y) * carry[1]) * bfhi(gg.x);
            const float y2 = (hlo(hl.z) + hhi(hl.z) * carry[2]) * bflo(gg.y), y3 = (hlo(hl.w) + hhi(hl.w) * carry[3]) * bfhi(gg.y);
            u32x2 w; w.x = pk2(y0, y1); w.y = pk2(y2, y3); *(u32x2*)(YR + off) = w; }
    }
}
DI void b2_merge(unsigned char* ws, int gtid, int nthr) {
    const bf16_t* OG = (const bf16_t*)(ws + WS_AR + AR_OG); const float* LSE = (const float*)(ws + WS_LSE); bf16_t* YA = (bf16_t*)(ws + WS_AR + AR_YA);
    for (int i = gtid; i < T * 64; i += nthr) {
        const int t = i >> 6, j = (i >> 4) & 3, d8 = i & 15;
        const float l0 = LSE[(size_t)t * 12 + j], l1 = LSE[(size_t)t * 12 + 4 + j], l2 = LSE[(size_t)t * 12 + 8 + j];
        const float mx = fmaxf(l0, fmaxf(l1, l2)); const float e0 = __expf(l0 - mx), e1 = __expf(l1 - mx), e2 = __expf(l2 - mx); const float inv = 1.0f / (e0 + e1 + e2);
        const float w0 = e0 * inv, w1 = e1 * inv, w2 = e2 * inv;
        const bf16_t* op = OG + (size_t)t * AW + j * 128 + 8 * d8;
        const u32x4 o0 = *(const u32x4*)op, o1 = *(const u32x4*)(op + 512), o2 = *(const u32x4*)(op + 1024);
        u32x4 w;
        w.x = pk2(w0 * bflo(o0.x) + w1 * bflo(o1.x) + w2 * bflo(o2.x), w0 * bfhi(o0.x) + w1 * bfhi(o1.x) + w2 * bfhi(o2.x));
        w.y = pk2(w0 * bflo(o0.y) + w1 * bflo(o1.y) + w2 * bflo(o2.y), w0 * bfhi(o0.y) + w1 * bfhi(o1.y) + w2 * bfhi(o2.y));
        w.z = pk2(w0 * bflo(o0.z) + w1 * bflo(o1.z) + w2 * bflo(o2.z), w0 * bfhi(o0.z) + w1 * bfhi(o1.z) + w2 * bfhi(o2.z));
        w.w = pk2(w0 * bflo(o0.w) + w1 * bflo(o1.w) + w2 * bflo(o2.w), w0 * bfhi(o0.w) + w1 * bfhi(o1.w) + w2 * bfhi(o2.w));
        *(u32x4*)(YA + (size_t)t * 512 + j * 128 + 8 * d8) = w;
    }
}

DI void e2_convact(const Args& a, int l, int gtid, int nthr) {
    unsigned char* ws = a.ws;
    const bf16_t* U = (const bf16_t*)(ws + WS_AR + AR_U); bf16_t* ACT = (bf16_t*)(ws + WS_AR + AR_ACT);
    const float* cw = (const float*)a.in[18] + (size_t)l * 3 * NUP; const float* cb = (const float*)a.in[19] + (size_t)l * NUP;
    for (int i = gtid; i < 1024 * 384; i += nthr) {
        const int c8 = i % 384, run = i / 384, c = 8 * c8; const int tstart = run * 16, p0 = tstart & (SEQ - 1);
        float wg[3][8], wv[3][8], bg[8], bv[8];
#pragma unroll
        for (int k = 0; k < 3; ++k) { const f32x4 g0 = *(const f32x4*)(cw + k * NUP + c), g1 = *(const f32x4*)(cw + k * NUP + c + 4), v0 = *(const f32x4*)(cw + k * NUP + DFF + c), v1 = *(const f32x4*)(cw + k * NUP + DFF + c + 4);
#pragma unroll
            for (int e = 0; e < 4; ++e) { wg[k][e] = g0[e]; wg[k][4 + e] = g1[e]; wv[k][e] = v0[e]; wv[k][4 + e] = v1[e]; } }
        { const f32x4 g0 = *(const f32x4*)(cb + c), g1 = *(const f32x4*)(cb + c + 4), v0 = *(const f32x4*)(cb + DFF + c), v1 = *(const f32x4*)(cb + DFF + c + 4);
#pragma unroll
          for (int e = 0; e < 4; ++e) { bg[e] = g0[e]; bg[4 + e] = g1[e]; bv[e] = v0[e]; bv[4 + e] = v1[e]; } }
        float g2[8], g1r[8], v2[8], v1r[8];
#pragma unroll
        for (int e = 0; e < 8; ++e) { g2[e] = 0.f; g1r[e] = 0.f; v2[e] = 0.f; v1r[e] = 0.f; }
        if (p0 >= 2) {
            const u32x4 ga = *(const u32x4*)(U + (size_t)(tstart - 2) * NUP + c), gb = *(const u32x4*)(U + (size_t)(tstart - 1) * NUP + c);
            const u32x4 va = *(const u32x4*)(U + (size_t)(tstart - 2) * NUP + DFF + c), vb = *(const u32x4*)(U + (size_t)(tstart - 1) * NUP + DFF + c);
            g2[0] = bflo(ga.x); g2[1] = bfhi(ga.x); g2[2] = bflo(ga.y); g2[3] = bfhi(ga.y); g2[4] = bflo(ga.z); g2[5] = bfhi(ga.z); g2[6] = bflo(ga.w); g2[7] = bfhi(ga.w);
            g1r[0] = bflo(gb.x); g1r[1] = bfhi(gb.x); g1r[2] = bflo(gb.y); g1r[3] = bfhi(gb.y); g1r[4] = bflo(gb.z); g1r[5] = bfhi(gb.z); g1r[6] = bflo(gb.w); g1r[7] = bfhi(gb.w);
            v2[0] = bflo(va.x); v2[1] = bfhi(va.x); v2[2] = bflo(va.y); v2[3] = bfhi(va.y); v2[4] = bflo(va.z); v2[5] = bfhi(va.z); v2[6] = bflo(va.w); v2[7] = bfhi(va.w);
            v1r[0] = bflo(vb.x); v1r[1] = bfhi(vb.x); v1r[2] = bflo(vb.y); v1r[3] = bfhi(vb.y); v1r[4] = bflo(vb.z); v1r[5] = bfhi(vb.z); v1r[6] = bflo(vb.w); v1r[7] = bfhi(vb.w);
        }
#pragma unroll 4
        for (int s = 0; s < 16; ++s) {
            const u32x4 gc = *(const u32x4*)(U + (size_t)(tstart + s) * NUP + c), vc = *(const u32x4*)(U + (size_t)(tstart + s) * NUP + DFF + c);
            float g0[8], v0[8];
            g0[0] = bflo(gc.x); g0[1] = bfhi(gc.x); g0[2] = bflo(gc.y); g0[3] = bfhi(gc.y); g0[4] = bflo(gc.z); g0[5] = bfhi(gc.z); g0[6] = bflo(gc.w); g0[7] = bfhi(gc.w);
            v0[0] = bflo(vc.x); v0[1] = bfhi(vc.x); v0[2] = bflo(vc.y); v0[3] = bfhi(vc.y); v0[4] = bflo(vc.z); v0[5] = bfhi(vc.z); v0[6] = bflo(vc.w); v0[7] = bfhi(vc.w);
            float o[8];
#pragma unroll
            for (int e = 0; e < 8; ++e) { const float ug = bg[e] + wg[0][e] * g2[e] + wg[1][e] * g1r[e] + wg[2][e] * g0[e]; const float uv = bv[e] + wv[0][e] * v2[e] + wv[1][e] * v1r[e] + wv[2][e] * v0[e];
                o[e] = gelu_tanh(ug) * uv; g2[e] = g1r[e]; g1r[e] = g0[e]; v2[e] = v1r[e]; v1r[e] = v0[e]; }
            u32x4 w; w.x = pk2(o[0], o[1]); w.y = pk2(o[2], o[3]); w.z = pk2(o[4], o[5]); w.w = pk2(o[6], o[7]);
            *(u32x4*)(ACT + (size_t)(tstart + s) * DFF + c) = w;
        }
    }
}

constexpr int NPHASE = 1 + 8 * DEPTH;
__global__ void __launch_bounds__(512, 2) mega(Args a) {
    extern __shared__ __attribute__((aligned(16))) unsigned char lds_raw[];
    LAS unsigned char* lds = (LAS unsigned char*)lds_raw;
    const int G = gridDim.x, NGW = G * 8, nthr = G * 512;
    unsigned char* ws = a.ws;
    volatile LAS unsigned* MISC = (volatile LAS unsigned*)(lds + MISC_OFF);
    if (threadIdx.x < 64) MISC[threadIdx.x] = 0u;
    __syncthreads();
    XcdBarrier bar; bar.bar = (unsigned*)(ws + WS_CTL); bar.x = 0; bar.st = MISC + 8;
    if (a.coop && !USE_CG_SYNC) bar = xcd_barrier_post((unsigned*)(ws + WS_CTL), MISC + 8);

    for (int ph = a.ph_lo; ph < a.ph_hi; ++ph) {
        int tid = threadIdx.x; asm volatile("" : "+v"(tid));
        const int lane = tid & 63, wave = __builtin_amdgcn_readfirstlane(tid >> 6);
        const int gw = blockIdx.x * 8 + wave, gtid = blockIdx.x * 512 + tid;
        if (ph == 0) {
          if (PHASE_MASK & 1) {
            convert_weights(a, 0, 15, lds, gw, NGW, wave, lane);
            p0_rows(a, gw, NGW, lane);
            p0_rope(a, gtid, nthr);
          }
        } else {
            const int l = (ph - 1) >> 3, sub = (ph - 1) & 7;
            float* xout = a.out;
            bf16_t* XB = (bf16_t*)(ws + WS_XB); float* ssp = (float*)(ws + WS_SSP);
            if (sub == 0 && (PHASE_MASK & 2)) {
                pg8::Gemm g{XB, (const bf16_t*)(ws + WS_W1T), T, NIN, DM}; pg8::StaticOrder S; S.init(T, NIN, G, (int)blockIdx.x);
                pg8::EpiIn E{ssp, (bf16_t*)(ws + WS_AR + AR_XR), (bf16_t*)(ws + WS_AR + AR_GG), (bf16_t*)(ws + WS_AR + AR_SGR), (bf16_t*)(ws + WS_AR + AR_SGA),
                             (bf16_t*)(ws + WS_AR + AR_Q), (bf16_t*)(ws + WS_AR + AR_K), (bf16_t*)(ws + WS_AR + AR_V),
                             (const float*)a.in[11] + (size_t)l * AW, (const float*)a.in[12] + (size_t)l * AW, (const float*)(ws + WS_COS), (const float*)(ws + WS_SIN), (LAS float*)(lds + TAB_OFF)};
                pg8::gemm_phase(lds, g, S, E);
            } else if (sub == 1 && (PHASE_MASK & 4)) {
                for (int it = blockIdx.x; it < 2048; it += G) lru_item(a, l, lds, it, tid, wave, lane);
                for (int it = gw; it < NBATCH * 12 * 64; it += NGW) attn_item(ws, it, lane);
            } else if (sub == 2 && (PHASE_MASK & 8)) {
                b2_fix(a, tid);
                b2_merge(ws, gtid, nthr);
                if (l + 1 < DEPTH) convert_weights(a, l + 1, 3, lds, gw, NGW, wave, lane);
                if (l >= 1) convert_weights(a, l, 4, lds, gw, NGW, wave, lane);
            } else if (sub == 3 && (PHASE_MASK & 16)) {
                { pg8::Gemm g{(const bf16_t*)(ws + WS_AR + AR_YR), (const bf16_t*)(ws + WS_PRT), T, DM, DM}; pg8::StaticOrder S; S.init(T, DM, G, (int)blockIdx.x);
                  pg8::EpiProj1 E{(const bf16_t*)(ws + WS_AR + AR_SGR), (float*)(ws + WS_AR + AR_TMP)}; pg8::gemm_phase(lds, g, S, E); }
                { pg8::Gemm g{(const bf16_t*)(ws + WS_AR + AR_YA), (const bf16_t*)(ws + WS_PAT), T, DM, 512}; pg8::StaticOrder S; S.init(T, DM, G, (int)blockIdx.x);
                  pg8::EpiProj2 E{(const bf16_t*)(ws + WS_AR + AR_SGA), (const float*)(ws + WS_AR + AR_TMP), (bf16_t*)(ws + WS_AR + AR_MG)}; pg8::gemm_phase(lds, g, S, E); }
            } else if (sub == 4 && (PHASE_MASK & 32)) {
                pg8::Gemm g{(const bf16_t*)(ws + WS_AR + AR_MG), (const bf16_t*)(ws + WS_WOT), T, DM, DM}; pg8::StaticOrder S; S.init(T, DM, G, (int)blockIdx.x);
                pg8::EpiResid E{l == 0 ? (const float*)a.in[0] : (const float*)xout, xout, XB, ssp}; pg8::gemm_phase(lds, g, S, E);
            } else if (sub == 5 && (PHASE_MASK & 64)) {
                pg8::Gemm g{XB, (const bf16_t*)(ws + WS_WUT), T, NUP, DM}; pg8::StaticOrder S; S.init(T, NUP, G, (int)blockIdx.x);
                pg8::EpiUp E{ssp, (bf16_t*)(ws + WS_AR + AR_U)}; pg8::gemm_phase(lds, g, S, E);
            } else if (sub == 6 && (PHASE_MASK & 128)) {
                e2_convact(a, l, gtid, nthr);
                if (l + 1 < DEPTH) convert_weights(a, l + 1, 8, lds, gw, NGW, wave, lane);
            } else if (sub == 7 && (PHASE_MASK & 256)) {
                pg8::Gemm g{(const bf16_t*)(ws + WS_AR + AR_ACT), (const bf16_t*)(ws + WS_WDT), T, DM, DFF}; pg8::StaticOrder S; S.init(T, DM, G, (int)blockIdx.x);
                pg8::EpiResid E{(const float*)xout, xout, XB, ssp}; pg8::gemm_phase(lds, g, S, E);
            }
        }
        if (ph + 1 < a.ph_hi) {
            if (USE_CG_SYNC || ph == 0) { cg::this_grid().sync(); }
            else xcd_barrier(bar);
        }
    }
}

extern "C" void kernel_launch(void* const* d_in, const int* in_sizes, int n_in, void* d_out, int out_size, void* d_ws, size_t ws_size, hipStream_t stream) {
    static int grid = 0;
    if (grid == 0) {
        if (n_in != 21 || out_size != T * DM || ws_size < WS_END) { fprintf(stderr, "kernel_launch: unexpected shapes (n_in %d out %d ws %zu, need %zu)\n", n_in, out_size, ws_size, (size_t)WS_END); grid = -1; return; }
        int dev = 0, cus = 0, per_cu = 0;
        hipGetDevice(&dev); hipDeviceGetAttribute(&cus, hipDeviceAttributeMultiprocessorCount, dev);
        if (hipFuncSetAttribute((const void*)mega, hipFuncAttributeMaxDynamicSharedMemorySize, LDS_BYTES) != hipSuccess) { fprintf(stderr, "kernel_launch: hipFuncSetAttribute failed\n"); grid = -1; return; }
        if (hipOccupancyMaxActiveBlocksPerMultiprocessor(&per_cu, (const void*)mega, 512, LDS_BYTES) != hipSuccess || per_cu < 1) { fprintf(stderr, "kernel_launch: occupancy query says %d\n", per_cu); per_cu = 1; }
        (void)hipGetLastError();
        grid = cus * 1;
        fprintf(stderr, "kernel_launch: grid %d (cus %d, per_cu %d)\n", grid, cus, per_cu);
    }
    if (grid < 0) return;
    Args a{};
    for (int i = 0; i < 21; ++i) a.in[i] = d_in[i];
    a.out = (float*)d_out; a.ws = (unsigned char*)d_ws; a.pad = 0;
#if MK_MULTI
    for (int p = 0; p < DBG_NPH; ++p) { a.ph_lo = p; a.ph_hi = p + 1; a.coop = 0; hipLaunchKernelGGL(mega, dim3(grid), dim3(512), LDS_BYTES, stream, a); }
#else
    hipMemsetAsync((char*)d_ws + WS_CTL, 0, CTL_BYTES, stream);
    a.ph_lo = 0; a.ph_hi = NPHASE; a.coop = 1;
    void* args[] = {&a};
    hipError_t e = hipLaunchCooperativeKernel((const void*)mega, dim3(grid), dim3(512), args, LDS_BYTES, stream);
    if (e != hipSuccess) fprintf(stderr, "kernel_launch: cooperative launch failed: %s (grid %d)\n", hipGetErrorString(e), grid);
#endif
}
```

```cpp
#include <hip/hip_runtime.h>
#include <hip/hip_cooperative_groups.h>
#include <cstdio>
namespace cg = cooperative_groups;

#ifndef MK_MULTI
#define MK_MULTI 0
#endif
#ifndef PHASE_MASK
#define PHASE_MASK 0x1ff
#endif
#ifndef PROBE_SEL
#define PROBE_SEL -1
#endif
#ifndef DBG_NPH
#define DBG_NPH 33
#endif
#ifndef USE_CG_SYNC
#define USE_CG_SYNC 0
#endif

#define DI __device__ __forceinline__
#define LAS __attribute__((address_space(3)))
typedef unsigned short bf16_t;
typedef short bf16x8 __attribute__((ext_vector_type(8)));
typedef float f32x2 __attribute__((ext_vector_type(2)));
typedef float f32x4 __attribute__((ext_vector_type(4)));
typedef float f32x16 __attribute__((ext_vector_type(16)));
typedef unsigned u32x2 __attribute__((ext_vector_type(2)));
typedef unsigned u32x4 __attribute__((ext_vector_type(4)));
typedef __bf16 bf16x2v __attribute__((ext_vector_type(2)));
typedef short s16x4 __attribute__((ext_vector_type(4)));

constexpr int T = 16384, SEQ = 2048, NBATCH = 8, DEPTH = 4;
constexpr int DM = 1024, NIN = 8704, AW = 1536, DFF = 3072, NUP = 6144;
constexpr float EPS = 1e-6f;

constexpr size_t MiB = 1u << 20;
constexpr size_t WS_CTL = 0, CTL_BYTES = 1 * MiB;
constexpr size_t WS_SSP = 1 * MiB;
constexpr size_t WS_AGGA = 2 * MiB, WS_AGGH = 3 * MiB;
constexpr size_t WS_LSE = 4 * MiB;
constexpr size_t WS_COS = 5 * MiB, WS_SIN = 9 * MiB;
constexpr size_t WS_W1T = 13 * MiB;
constexpr size_t WS_WUT = 30 * MiB;
constexpr size_t WS_WDT = 42 * MiB;
constexpr size_t WS_PRT = 48 * MiB;
constexpr size_t WS_PAT = 50 * MiB;
constexpr size_t WS_WOT = 51 * MiB;
constexpr size_t WS_WAT = 53 * MiB;
constexpr size_t WS_WXT = 53 * MiB + 262144;
constexpr size_t WS_XB = 54 * MiB;
constexpr size_t WS_AR = 86 * MiB;
constexpr size_t AR_XR = 0, AR_YR = 0;
constexpr size_t AR_GG = 32 * MiB, AR_MG = 32 * MiB;
constexpr size_t AR_SGR = 64 * MiB, AR_SGA = 96 * MiB;
constexpr size_t AR_Q = 128 * MiB, AR_K = 176 * MiB, AR_V = 224 * MiB;
constexpr size_t AR_YA = 128 * MiB, AR_TMP = 144 * MiB;
constexpr size_t AR_HL = 272 * MiB, AR_OG = 336 * MiB;
constexpr size_t AR_U = 0, AR_ACT = 192 * MiB;
constexpr size_t WS_END = WS_AR + 384 * MiB;

constexpr int RING_BYTES = 131072;
constexpr int TAB_OFF = RING_BYTES;
constexpr int MISC_OFF = RING_BYTES + 8192;
constexpr int LDS_BYTES = 147456;

#define LDS_WAIT() asm volatile("s_waitcnt lgkmcnt(0)" ::: "memory")
DI unsigned f2bf(float f) { unsigned u = __builtin_bit_cast(unsigned, f); return (u + 0x7fffu + ((u >> 16) & 1u)) >> 16; }
DI unsigned pk2(float lo, float hi) { f32x2 v = {lo, hi}; return __builtin_bit_cast(unsigned, __builtin_convertvector(v, bf16x2v)); }
DI float bflo(unsigned w) { return __builtin_bit_cast(float, w << 16); }
DI float bfhi(unsigned w) { return __builtin_bit_cast(float, w & 0xffff0000u); }
DI float frcp(float x) { return __builtin_amdgcn_rcpf(x); }
DI float fexp(float x) { return __builtin_amdgcn_exp2f(x * 1.4426950408889634f); }
DI float sigmoidf_(float x) { return frcp(1.0f + fexp(-x)); }
DI float gelu_tanh(float x) { const float y = 1.5957691216057308f * (x + 0.044715f * x * x * x); return x * frcp(1.0f + fexp(-y)); }
DI float one_minus_exp(float y) { const float ser = -y * (1.0f + y * (0.5f + y * (0.16666667f + y * (0.041666668f + y * (0.0083333333f + y * 0.0013888889f))))); return (y > -0.3f) ? ser : (1.0f - fexp(y)); }
DI unsigned pkh2(float lo, float hi) { const _Float16 a = (_Float16)lo, b = (_Float16)hi; return (unsigned)__builtin_bit_cast(unsigned short, a) | ((unsigned)__builtin_bit_cast(unsigned short, b) << 16); }
DI float hlo(unsigned w) { return (float)__builtin_bit_cast(_Float16, (unsigned short)(w & 0xffffu)); }
DI float hhi(unsigned w) { return (float)__builtin_bit_cast(_Float16, (unsigned short)(w >> 16)); }

namespace pg8 {
constexpr int BM = 256, BK = 64, HALF = 128, HTB = HALF * BK * 2, NXCD = 8, WGM = 8;
DI int lds_byte(int r, int c) { const int st = (r >> 4) * 2 + (c >> 5), rr = r & 15, cc = c & 31, ob = rr * 64 + cc * 2; return st * 1024 + (ob ^ (((ob >> 9) & 1) << 5)); }
DI void stage_rc(int b, int& R, int& C) { const int st = b / 1024, sb = b % 1024, swz = sb ^ (((sb >> 9) & 1) << 5); R = (st >> 1) * 16 + swz / 64; C = (st & 1) * 32 + (swz % 64) / 2; }
DI int perm32(int rho) { const int n = rho >> 4, i = rho & 15; return 8 * (i >> 2) + 4 * n + (i & 3); }
struct Unit { int pm, pn; };
struct Gemm { const bf16_t* A; const bf16_t* Bt; int M, N, K; };
struct StaticOrder {
    int nM, nN, nwg, G, c;
    DI void init(int M, int N, int G_, int c_) { nM = M / BM; nN = N / BM; nwg = nM * nN; G = G_; c = c_; }
    DI bool next(int i, Unit& u) const {
        const long L = (long)i * G + c; if (L >= nwg) return false;
        int wgid = (int)L; { const int q = nwg / NXCD, r = nwg % NXCD, xcd = wgid % NXCD, off = wgid / NXCD; wgid = (xcd < r ? xcd * (q + 1) : r * (q + 1) + (xcd - r) * q) + off; }
        const int nig = WGM * nN, gid = wgid / nig, fm = gid * WGM, gsz = (nM - fm) < WGM ? (nM - fm) : WGM;
        u.pm = fm + ((wgid % nig) % gsz); u.pn = (wgid % nig) / gsz; return true;
    }
};
DI unsigned cvt_pk_bf16(float lo, float hi) { return pk2(lo, hi); }

template <class Epi, bool ALIGN_EPI = true, bool SP2 = true>
DI void gemm_phase(LAS unsigned char* lds, const Gemm g, const StaticOrder& S, const Epi& E) {
    int tid = threadIdx.x; asm volatile("" : "+v"(tid));
    const int wid = __builtin_amdgcn_readfirstlane(tid >> 6), lane = tid & 63, wr = wid >> 2, wc = wid & 3, fr = lane & 15, fq = lane >> 4;
    const int K = g.K, nt = K / BK;
    unsigned voffA[2], voffB[2];
#pragma unroll
    for (int i = 0; i < 2; ++i) { int R, C; stage_rc(tid * 16 + i * 8192, R, C); const int Rb = (R & ~31) + perm32(R & 31);
        voffA[i] = (unsigned)(R * K + C) * 2u; voffB[i] = (unsigned)(Rb * K + C) * 2u; }
    const size_t kstep = (size_t)(BK * 2);
    const size_t hstep = (size_t)HALF * K * 2;
    const size_t tstep = 2 * hstep;
    const unsigned ldsw = (unsigned)wid * 1024u;
    const int aoff = lds_byte(wr * 64 + fr, fq * 8), boff = lds_byte(wc * 32 + fr, fq * 8);
#define PG8_SA(b, h) (((b) * 2 + (h)) * HTB)
#define PG8_SB(b, h) ((4 + (b) * 2 + (h)) * HTB)
#define PG8_STAGE(bufoff, gbase, voff) do { _Pragma("unroll") for (int _i = 0; _i < 2; ++_i) \
        __builtin_amdgcn_global_load_lds((const unsigned*)((const char*)(gbase) + (voff)[_i]), (LAS unsigned*)(lds + (bufoff) + ldsw + _i * 8192), 16, 0, 0); } while (0)
#define PG8_LDA(dst, b, h) do { _Pragma("unroll") for (int m = 0; m < 4; ++m) _Pragma("unroll") for (int k = 0; k < 2; ++k) dst[m][k] = *(const LAS bf16x8*)(lds + PG8_SA(b, h) + aoff + m * 2048 + k * 1024); } while (0)
#define PG8_LDB(dst, b, h) do { _Pragma("unroll") for (int n = 0; n < 2; ++n) _Pragma("unroll") for (int k = 0; k < 2; ++k) dst[n][k] = *(const LAS bf16x8*)(lds + PG8_SB(b, h) + boff + n * 2048 + k * 1024); } while (0)
#define PG8_MMA(ai, bj, At, Bt) do { __builtin_amdgcn_s_setprio(1); _Pragma("unroll") for (int m = 0; m < 4; ++m) _Pragma("unroll") for (int n = 0; n < 2; ++n) _Pragma("unroll") for (int k = 0; k < 2; ++k) \
        acc[ai][bj][m][n] = __builtin_amdgcn_mfma_f32_16x16x32_bf16(Bt[n][k], At[m][k], acc[ai][bj][m][n], 0, 0, 0); __builtin_amdgcn_s_setprio(0); } while (0)
#define PG8_WAIT_V(n) asm volatile("s_waitcnt vmcnt(" #n ")" ::: "memory")
#define PG8_WAIT_L(n) asm volatile("s_waitcnt lgkmcnt(" #n ")" ::: "memory")
#define PG8_BAR __builtin_amdgcn_s_barrier()
#define PG8_SCHED __builtin_amdgcn_sched_barrier(0)
    Unit cur, nxt; int ui = 0;
    if (!S.next(0, cur)) return;
    f32x4 acc[2][2][4][2];
#pragma unroll
    for (int a = 0; a < 2; ++a)
#pragma unroll
        for (int b = 0; b < 2; ++b)
#pragma unroll
            for (int m = 0; m < 4; ++m)
#pragma unroll
                for (int n = 0; n < 2; ++n) acc[a][b][m][n] = (f32x4){0.f, 0.f, 0.f, 0.f};
    bf16x8 At[4][2], B0[2][2], B1[2][2];
    const char* cA = (const char*)g.A + (size_t)cur.pm * tstep; const char* cB = (const char*)g.Bt + (size_t)cur.pn * tstep;
    if constexpr (SP2) {
        PG8_STAGE(PG8_SB(0, 0), cB, voffB); PG8_STAGE(PG8_SB(0, 1), cB + hstep, voffB); PG8_STAGE(PG8_SA(0, 0), cA, voffA); PG8_STAGE(PG8_SA(0, 1), cA + hstep, voffA);
        if (wr == 1) PG8_BAR;
        PG8_WAIT_V(2); PG8_BAR;
        PG8_STAGE(PG8_SB(1, 0), cB + kstep, voffB); PG8_STAGE(PG8_SA(1, 0), cA + kstep, voffA); PG8_STAGE(PG8_SB(1, 1), cB + hstep + kstep, voffB);
        PG8_WAIT_V(6); PG8_BAR;
    } else {
        PG8_STAGE(PG8_SB(0, 0), cB, voffB); PG8_STAGE(PG8_SA(0, 0), cA, voffA); PG8_STAGE(PG8_SB(0, 1), cB + hstep, voffB); PG8_STAGE(PG8_SA(0, 1), cA + hstep, voffA);
        if (wr == 1) PG8_BAR;
        PG8_WAIT_V(4); PG8_BAR;
        PG8_STAGE(PG8_SB(1, 0), cB + kstep, voffB); PG8_STAGE(PG8_SA(1, 0), cA + kstep, voffA); PG8_STAGE(PG8_SB(1, 1), cB + hstep + kstep, voffB);
        PG8_WAIT_V(6); PG8_BAR;
    }
    for (;;) {
        const bool has_next = S.next(ui + 1, nxt);
        const char* nA = has_next ? (const char*)g.A + (size_t)nxt.pm * tstep : cA; const char* nB = has_next ? (const char*)g.Bt + (size_t)nxt.pn * tstep : cB;
        for (int t = 0; t < nt; t += 2) {
            const bool last = (t == nt - 2);
            const char* a1 = cA + (size_t)(t + 1) * kstep;
            const char* a2 = last ? nA : cA + (size_t)(t + 2) * kstep; const char* b2 = last ? nB : cB + (size_t)(t + 2) * kstep;
            const char* a3 = a2 + kstep; const char* b3 = b2 + kstep;
            if constexpr (SP2) {
            PG8_LDB(B0, 0, 0); PG8_LDB(B1, 0, 1); PG8_SCHED; PG8_LDA(At, 0, 0); PG8_STAGE(PG8_SA(1, 1), a1 + hstep, voffA);
            PG8_WAIT_V(8); PG8_WAIT_L(0); PG8_BAR; PG8_MMA(0, 0, At, B0); PG8_MMA(0, 1, At, B1); PG8_BAR; PG8_SCHED;
            PG8_LDA(At, 0, 1); PG8_STAGE(PG8_SB(0, 0), b2, voffB); PG8_STAGE(PG8_SB(0, 1), b2 + hstep, voffB); PG8_STAGE(PG8_SA(0, 0), a2, voffA);
            PG8_WAIT_V(8); PG8_WAIT_L(0); PG8_BAR; PG8_MMA(1, 0, At, B0); PG8_MMA(1, 1, At, B1); PG8_BAR; PG8_SCHED;
            PG8_LDB(B0, 1, 0); PG8_LDB(B1, 1, 1); PG8_SCHED; PG8_LDA(At, 1, 0); PG8_STAGE(PG8_SA(0, 1), a2 + hstep, voffA);
            PG8_WAIT_V(8); PG8_WAIT_L(0); PG8_BAR; PG8_MMA(0, 0, At, B0); PG8_MMA(0, 1, At, B1); PG8_BAR; PG8_SCHED;
            PG8_LDA(At, 1, 1); PG8_STAGE(PG8_SB(1, 0), b3, voffB); PG8_STAGE(PG8_SB(1, 1), b3 + hstep, voffB); PG8_STAGE(PG8_SA(1, 0), a3, voffA);
            PG8_WAIT_V(8); PG8_WAIT_L(0); PG8_BAR; PG8_MMA(1, 0, At, B0); PG8_MMA(1, 1, At, B1); PG8_BAR; PG8_SCHED;
            } else {
            PG8_LDB(B0, 0, 0); PG8_SCHED; PG8_LDA(At, 0, 0); PG8_STAGE(PG8_SA(1, 1), a1 + hstep, voffA);
            PG8_WAIT_L(8); PG8_BAR; PG8_WAIT_L(0); PG8_MMA(0, 0, At, B0); PG8_BAR; PG8_SCHED;
            PG8_LDB(B1, 0, 1); PG8_STAGE(PG8_SB(0, 0), b2, voffB);
            PG8_BAR; PG8_WAIT_L(0); PG8_MMA(0, 1, At, B1); PG8_BAR;
            PG8_LDA(At, 0, 1); PG8_STAGE(PG8_SA(0, 0), a2, voffA);
            PG8_BAR; PG8_WAIT_L(0); PG8_MMA(1, 0, At, B0); PG8_BAR; PG8_SCHED;
            PG8_STAGE(PG8_SB(0, 1), b2 + hstep, voffB);
            PG8_WAIT_V(6); PG8_BAR; PG8_MMA(1, 1, At, B1); PG8_BAR;
            PG8_LDB(B0, 1, 0); PG8_SCHED; PG8_LDA(At, 1, 0); PG8_STAGE(PG8_SA(0, 1), a2 + hstep, voffA);
            PG8_WAIT_L(8); PG8_BAR; PG8_WAIT_L(0); PG8_MMA(0, 0, At, B0); PG8_BAR; PG8_SCHED;
            PG8_LDB(B1, 1, 1); PG8_STAGE(PG8_SB(1, 0), b3, voffB);
            PG8_BAR; PG8_WAIT_L(0); PG8_MMA(0, 1, At, B1); PG8_BAR;
            PG8_LDA(At, 1, 1); PG8_STAGE(PG8_SA(1, 0), a3, voffA);
            PG8_BAR; PG8_WAIT_L(0); PG8_MMA(1, 0, At, B0); PG8_BAR; PG8_SCHED;
            PG8_STAGE(PG8_SB(1, 1), b3 + hstep, voffB);
            PG8_WAIT_V(6); PG8_BAR; PG8_MMA(1, 1, At, B1); PG8_BAR;
            }
        }
        if constexpr (ALIGN_EPI) { if (wr == 0) PG8_BAR; }
        E(acc, cur, wr, wc, fr, fq);
        if (!has_next) break;
#pragma unroll
        for (int a = 0; a < 2; ++a)
#pragma unroll
            for (int b = 0; b < 2; ++b)
#pragma unroll
                for (int m = 0; m < 4; ++m)
#pragma unroll
                    for (int n = 0; n < 2; ++n) acc[a][b][m][n] = (f32x4){0.f, 0.f, 0.f, 0.f};
        cur = nxt; cA = nA; cB = nB; ++ui;
        if constexpr (ALIGN_EPI) { if (wr == 1) PG8_BAR; }
    }
    PG8_WAIT_V(0);
    if constexpr (!ALIGN_EPI) { if (wr == 0) PG8_BAR; }
    PG8_BAR;
#undef PG8_SA
#undef PG8_SB
#undef PG8_STAGE
#undef PG8_LDA
#undef PG8_LDB
#undef PG8_MMA
#undef PG8_WAIT_V
#undef PG8_WAIT_L
#undef PG8_BAR
#undef PG8_SCHED
}

typedef f32x4 Acc[2][2][4][2];

DI void row_scales(const float* ssp, int row0, int fq, float (&rs)[2][4]) {
#pragma unroll
    for (int ai = 0; ai < 2; ++ai)
#pragma unroll
        for (int m = 0; m < 4; ++m) {
            const f32x4 p = *(const f32x4*)(ssp + (size_t)(row0 + ai * HALF + m * 16) * 16 + 4 * fq);
            float s = (p.x + p.y) + (p.z + p.w); s += __shfl_xor(s, 16); s += __shfl_xor(s, 32);
            rs[ai][m] = rsqrtf(s * (1.0f / 1024.0f) + EPS);
        }
}

DI float row_scale1(const float* ssp, int row, int fq) {
    const f32x4 p = *(const f32x4*)(ssp + (size_t)row * 16 + 4 * fq);
    float s = (p.x + p.y) + (p.z + p.w); s += __shfl_xor(s, 16); s += __shfl_xor(s, 32);
    return rsqrtf(s * (1.0f / 1024.0f) + EPS);
}
template <int ACT> DI void store_plain(Acc& acc, const float* ssp, bf16_t* O, int ldc, int row0, int col0, int fq) {
    float rs[2][4]; row_scales(ssp, row0, fq, rs);
#pragma unroll
    for (int ai = 0; ai < 2; ++ai)
#pragma unroll
        for (int m = 0; m < 4; ++m) { int r0v = row0; asm volatile("" : "+v"(r0v)); const int row = r0v + ai * HALF + m * 16; bf16_t* rowp = O + (size_t)row * ldc + col0; const float s = rs[ai][m];
#pragma unroll
            for (int bj = 0; bj < 2; ++bj) { f32x4 v0 = acc[ai][bj][m][0] * s, v1 = acc[ai][bj][m][1] * s;
                if (ACT == 1) {
#pragma unroll
                    for (int j = 0; j < 4; ++j) { v0[j] = gelu_tanh(v0[j]); v1[j] = gelu_tanh(v1[j]); } }
                if (ACT == 2) {
#pragma unroll
                    for (int j = 0; j < 4; ++j) { v0[j] = sigmoidf_(v0[j]); v1[j] = sigmoidf_(v1[j]); } }
                u32x4 w; w.x = cvt_pk_bf16(v0[0], v0[1]); w.y = cvt_pk_bf16(v0[2], v0[3]); w.z = cvt_pk_bf16(v1[0], v1[1]); w.w = cvt_pk_bf16(v1[2], v1[3]);
                *(u32x4*)(rowp + bj * HALF) = w; } }
}
struct EpiIn {
    const float* ssp; bf16_t *XR, *GG, *SGR, *SGA, *Q, *Kc, *V; const float *qg, *kg, *cosT, *sinT; LAS float* tab;
    DI void operator()(Acc& acc, const Unit& u, int wr, int wc, int fr, int fq) const {
        const int row0 = u.pm * BM + wr * 64 + fr, pn = u.pn;
        if (pn < 16 || pn >= 28) {
            const int cw = wc * 32 + 8 * fq;
            if (pn < 4) store_plain<0>(acc, ssp, XR, 1024, row0, pn * 256 + cw, fq);
            else if (pn < 8) store_plain<1>(acc, ssp, GG, 1024, row0, (pn - 4) * 256 + cw, fq);
            else if (pn < 12) store_plain<2>(acc, ssp, SGR, 1024, row0, (pn - 8) * 256 + cw, fq);
            else if (pn < 16) store_plain<2>(acc, ssp, SGA, 1024, row0, (pn - 12) * 256 + cw, fq);
            else store_plain<0>(acc, ssp, V, 1536, row0, (pn - 28) * 256 + cw, fq);
        } else {
            const bool isq = pn < 22; const int head0 = 2 * (pn - (isq ? 16 : 22)); bf16_t* O = isq ? Q : Kc; const float* gw = isq ? qg : kg; const float osc = isq ? 0.08838834764831845f : 1.0f;
            const int d0 = 16 * wc + 4 * fq;
            float rs[2][4]; row_scales(ssp, row0, fq, rs);
#pragma unroll
            for (int ai = 0; ai < 2; ++ai)
#pragma unroll
                for (int m = 0; m < 4; ++m) { int r0v = row0; asm volatile("" : "+v"(r0v)); const float s = rs[ai][m]; const int rl = (r0v & 255) + ai * HALF + m * 16;
#pragma unroll
                    for (int bj = 0; bj < 2; ++bj) { const f32x4 a = acc[ai][bj][m][0], b = acc[ai][bj][m][1];
                        float q = (a[0] * a[0] + a[1] * a[1]) + (a[2] * a[2] + a[3] * a[3]) + (b[0] * b[0] + b[1] * b[1]) + (b[2] * b[2] + b[3] * b[3]);
                        q *= s * s; q += __shfl_xor(q, 16); q += __shfl_xor(q, 32);
                        if (fq == 0) tab[(rl * 2 + bj) * 4 + wc] = q; } }
            asm volatile("s_waitcnt lgkmcnt(0)" ::: "memory"); __builtin_amdgcn_s_barrier(); asm volatile("" ::: "memory");
            const f32x4 g1a = *(const f32x4*)(gw + head0 * 128 + d0), g2a = *(const f32x4*)(gw + head0 * 128 + 64 + d0);
            const f32x4 g1b = *(const f32x4*)(gw + head0 * 128 + 128 + d0), g2b = *(const f32x4*)(gw + head0 * 128 + 192 + d0);
#pragma unroll
            for (int ai = 0; ai < 2; ++ai)
#pragma unroll
                for (int m = 0; m < 4; ++m) { int r0v = row0; asm volatile("" : "+v"(r0v)); const int rl = (r0v & 255) + ai * HALF + m * 16; const size_t row = (size_t)(r0v + ai * HALF + m * 16);
                    const f32x4 cs = *(const f32x4*)(cosT + row * 64 + d0), sn = *(const f32x4*)(sinT + row * 64 + d0); const float s = rs[ai][m] * osc;
#pragma unroll
                    for (int bj = 0; bj < 2; ++bj) { const f32x4 pp = *(const LAS f32x4*)(tab + (rl * 2 + bj) * 4);
                        const float inv = rsqrtf(((pp.x + pp.y) + (pp.z + pp.w)) * (1.0f / 128.0f) + EPS) * s;
                        const f32x4 x1 = acc[ai][bj][m][0] * inv * (bj ? g1b : g1a), x2 = acc[ai][bj][m][1] * inv * (bj ? g2b : g2a);
                        const f32x4 o1 = x1 * cs - x2 * sn, o2 = x2 * cs + x1 * sn;
                        u32x2 w1, w2; w1.x = cvt_pk_bf16(o1[0], o1[1]); w1.y = cvt_pk_bf16(o1[2], o1[3]); w2.x = cvt_pk_bf16(o2[0], o2[1]); w2.y = cvt_pk_bf16(o2[2], o2[3]);
                        bf16_t* p = O + row * AW + (head0 + bj) * 128 + d0; *(u32x2*)p = w1; *(u32x2*)(p + 64) = w2; }
                    if (m & 1) asm volatile("" ::: "memory"); }
        }
    }
};
struct EpiProj1 {
    const bf16_t* SG; bf16_t* TMP;
    DI void operator()(Acc& acc, const Unit& u, int wr, int wc, int fr, int fq) const {
        const int row0 = u.pm * BM + wr * 64 + fr, col0 = u.pn * BM + wc * 32 + 8 * fq;
#pragma unroll
        for (int ai = 0; ai < 2; ++ai)
#pragma unroll
            for (int m = 0; m < 4; ++m) { int r0v = row0; asm volatile("" : "+v"(r0v)); const size_t off = (size_t)(r0v + ai * HALF + m * 16) * DM + col0;
#pragma unroll
                for (int bj = 0; bj < 2; ++bj) { const u32x4 sg = *(const u32x4*)(SG + off + bj * HALF);
                    f32x4 v0 = acc[ai][bj][m][0], v1 = acc[ai][bj][m][1];
                    v0[0] *= bflo(sg.x); v0[1] *= bfhi(sg.x); v0[2] *= bflo(sg.y); v0[3] *= bfhi(sg.y); v1[0] *= bflo(sg.z); v1[1] *= bfhi(sg.z); v1[2] *= bflo(sg.w); v1[3] *= bfhi(sg.w);
                    u32x4 w; w.x = cvt_pk_bf16(v0[0], v0[1]); w.y = cvt_pk_bf16(v0[2], v0[3]); w.z = cvt_pk_bf16(v1[0], v1[1]); w.w = cvt_pk_bf16(v1[2], v1[3]);
                    *(u32x4*)(TMP + off + bj * HALF) = w; }
                if (m & 1) asm volatile("" ::: "memory"); }
    }
};
struct EpiProj2 {
    const bf16_t* SG; const bf16_t* TMP; bf16_t* MG;
    DI void operator()(Acc& acc, const Unit& u, int wr, int wc, int fr, int fq) const {
        const int row0 = u.pm * BM + wr * 64 + fr, col0 = u.pn * BM + wc * 32 + 8 * fq;
#pragma unroll
        for (int ai = 0; ai < 2; ++ai)
#pragma unroll
            for (int m = 0; m < 4; ++m) { int r0v = row0; asm volatile("" : "+v"(r0v)); const size_t off = (size_t)(r0v + ai * HALF + m * 16) * DM + col0;
#pragma unroll
                for (int bj = 0; bj < 2; ++bj) { const u32x4 sg = *(const u32x4*)(SG + off + bj * HALF); const u32x4 tm = *(const u32x4*)(TMP + off + bj * HALF);
                    f32x4 v0 = acc[ai][bj][m][0], v1 = acc[ai][bj][m][1];
                    v0[0] = bflo(tm.x) + v0[0] * bflo(sg.x); v0[1] = bfhi(tm.x) + v0[1] * bfhi(sg.x); v0[2] = bflo(tm.y) + v0[2] * bflo(sg.y); v0[3] = bfhi(tm.y) + v0[3] * bfhi(sg.y);
                    v1[0] = bflo(tm.z) + v1[0] * bflo(sg.z); v1[1] = bfhi(tm.z) + v1[1] * bfhi(sg.z); v1[2] = bflo(tm.w) + v1[2] * bflo(sg.w); v1[3] = bfhi(tm.w) + v1[3] * bfhi(sg.w);
                    u32x4 w; w.x = cvt_pk_bf16(v0[0], v0[1]); w.y = cvt_pk_bf16(v0[2], v0[3]); w.z = cvt_pk_bf16(v1[0], v1[1]); w.w = cvt_pk_bf16(v1[2], v1[3]);
                    *(u32x4*)(MG + off + bj * HALF) = w; }
                if (m & 1) asm volatile("" ::: "memory"); }
    }
};
struct EpiResid {
    float* xout; bf16_t* XB; float* ssp; int final_;
    DI void operator()(Acc& acc, const Unit& u, int wr, int wc, int fr, int fq) const {
        const int row0 = u.pm * BM + wr * 64 + fr, col0 = u.pn * BM + wc * 32 + 8 * fq;
#pragma unroll
        for (int ai = 0; ai < 2; ++ai)
#pragma unroll
            for (int m = 0; m < 4; ++m) { int r0v = row0; asm volatile("" : "+v"(r0v)); const int row = r0v + ai * HALF + m * 16; const size_t off = (size_t)row * DM + col0; float q = 0.f;
#pragma unroll
                for (int bj = 0; bj < 2; ++bj) {
                    const u32x4 xo = *(const u32x4*)(XB + off + bj * HALF);
                    f32x4 o0 = acc[ai][bj][m][0], o1 = acc[ai][bj][m][1];
                    o0[0] += bflo(xo.x); o0[1] += bfhi(xo.x); o0[2] += bflo(xo.y); o0[3] += bfhi(xo.y); o1[0] += bflo(xo.z); o1[1] += bfhi(xo.z); o1[2] += bflo(xo.w); o1[3] += bfhi(xo.w);
                    q += (o0[0] * o0[0] + o0[1] * o0[1]) + (o0[2] * o0[2] + o0[3] * o0[3]) + (o1[0] * o1[0] + o1[1] * o1[1]) + (o1[2] * o1[2] + o1[3] * o1[3]);
                    if (final_) { *(f32x4*)(xout + off + bj * HALF) = o0; *(f32x4*)(xout + off + bj * HALF + 4) = o1; }
                    else { u32x4 w; w.x = cvt_pk_bf16(o0[0], o0[1]); w.y = cvt_pk_bf16(o0[2], o0[3]); w.z = cvt_pk_bf16(o1[0], o1[1]); w.w = cvt_pk_bf16(o1[2], o1[3]);
                        *(u32x4*)(XB + off + bj * HALF) = w; } }
                q += __shfl_xor(q, 16); q += __shfl_xor(q, 32);
                if (fq == 0) ssp[(size_t)row * 16 + u.pn * 4 + wc] = q;
                if (m & 1) asm volatile("" ::: "memory"); }
    }
};
struct EpiUp {
    const float* ssp; bf16_t* U;
    DI void operator()(Acc& acc, const Unit& u, int wr, int wc, int fr, int fq) const {
        const int row0 = u.pm * BM + wr * 64 + fr, col0 = u.pn * BM + wc * 32 + 8 * fq;
        float rs[2][4]; row_scales(ssp, row0, fq, rs);
#pragma unroll
        for (int ai = 0; ai < 2; ++ai)
#pragma unroll
            for (int m = 0; m < 4; ++m) { int r0v = row0; asm volatile("" : "+v"(r0v)); const int row = r0v + ai * HALF + m * 16; bf16_t* rowp = U + (size_t)row * NUP + col0; const float s = rs[ai][m];
#pragma unroll
                for (int bj = 0; bj < 2; ++bj) { const f32x4 v0 = acc[ai][bj][m][0] * s, v1 = acc[ai][bj][m][1] * s;
                    u32x4 w; w.x = cvt_pk_bf16(v0[0], v0[1]); w.y = cvt_pk_bf16(v0[2], v0[3]); w.z = cvt_pk_bf16(v1[0], v1[1]); w.w = cvt_pk_bf16(v1[2], v1[3]);
                    *(u32x4*)(rowp + bj * HALF) = w; } }
    }
};
}

#define XB_TMO      128
#define XB_XCNT(j)  (256  + 64 * (j))
#define XB_XSUB(j)  (1280 + 64 * (j))
#define XB_XGEN(j)  (2304 + 64 * (j))
#define XB_TOP      3328
#define XB_TOPGEN   3392
#define XB_SPIN_CAP (1u << 22)
DI unsigned xb_ld(unsigned* p)              { return __hip_atomic_load(p, __ATOMIC_RELAXED, __HIP_MEMORY_SCOPE_AGENT); }
DI unsigned xb_add(unsigned* p, unsigned v) { return __hip_atomic_fetch_add(p, v, __ATOMIC_RELAXED, __HIP_MEMORY_SCOPE_AGENT); }
DI unsigned xb_xcc_id() { return (unsigned)__builtin_amdgcn_s_getreg((3 << 11) | 20) & 0xFu; }
#define XB_SPIN(cond, bar) do { unsigned _sp = 0; while (cond) { __builtin_amdgcn_s_sleep(1); \
    if ((++_sp & 255u) == 0u) { if (xb_ld(&(bar)[XB_TMO])) break; if (_sp > XB_SPIN_CAP) { atomicAdd(&(bar)[XB_TMO], 1u); break; } } } } while (0)
struct XcdBarrier { unsigned* bar; unsigned x; volatile LAS unsigned* st; };
DI XcdBarrier xcd_barrier_post(unsigned* bar, volatile LAS unsigned* st) {
    XcdBarrier b; b.bar = bar; b.x = xb_xcc_id(); b.st = st;
    if (threadIdx.x == 0) (void)xb_add(&bar[XB_XCNT(b.x)], 1u);
    return b;
}
DI void xcd_barrier_complete(unsigned* bar, unsigned x, unsigned& nloc, unsigned& nx) {
    const unsigned G = gridDim.x * gridDim.y * gridDim.z;
    unsigned sum, cnt, mine, sp = 0u;
    for (;;) {
        sum = 0u; cnt = 0u; mine = 0u;
#pragma unroll
        for (unsigned j = 0; j < 16; ++j) { const unsigned c = xb_ld(&bar[XB_XCNT(j)]); sum += c; cnt += (c > 0u) ? 1u : 0u; mine = (j == x) ? c : mine; }
        if (sum == G) break;
        __builtin_amdgcn_s_sleep(1);
        if ((++sp & 255u) == 0u) { if (xb_ld(&bar[XB_TMO])) break; if (sp > XB_SPIN_CAP) { atomicAdd(&bar[XB_TMO], 1u); break; } }
    }
    nloc = mine > 0u ? mine : 1u; nx = cnt > 0u ? cnt : 1u;
}
DI void xcd_barrier(const XcdBarrier& b) {
    asm volatile("s_waitcnt vmcnt(0)" ::: "memory");
    __syncthreads();
    if (threadIdx.x == 0) {
        unsigned* bar = b.bar;
        __builtin_amdgcn_s_waitcnt(0);
        unsigned nloc = b.st[0], nx = b.st[1];
        if (nloc == 0u) { xcd_barrier_complete(bar, b.x, nloc, nx); b.st[0] = nloc; b.st[1] = nx; }
        const unsigned old = xb_add(&bar[XB_XSUB(b.x)], 1u);
        const unsigned gen = old / nloc;
        if (old + 1u == (gen + 1u) * nloc) {
            __builtin_amdgcn_fence(__ATOMIC_RELEASE, "agent");
            asm volatile("s_waitcnt vmcnt(0)" ::: "memory");
            const unsigned og = xb_add(&bar[XB_TOP], 1u);
            const unsigned tg = og / nx;
            if (og + 1u == (tg + 1u) * nx) xb_add(&bar[XB_TOPGEN], 1u);
            else XB_SPIN(xb_ld(&bar[XB_TOPGEN]) == tg, bar);
            __builtin_amdgcn_fence(__ATOMIC_ACQUIRE, "agent");
            xb_add(&bar[XB_XGEN(b.x)], 1u);
            asm volatile("s_waitcnt vmcnt(0)" ::: "memory");
        } else {
            XB_SPIN(xb_ld(&bar[XB_XGEN(b.x)]) == gen, bar);
            __builtin_amdgcn_fence(__ATOMIC_ACQUIRE, "agent");
            asm volatile("s_waitcnt vmcnt(0)" ::: "memory");
        }
    }
    __syncthreads();
}

struct Args { const void* in[21]; float* out; unsigned char* ws; int ph_lo, ph_hi, coop, pad; };
typedef const Args __attribute__((address_space(4)))* CArgsP;
#define GAS1 __attribute__((address_space(1)))
DI const float* inF(CArgsP a, int k) { return (const float*)(GAS1 const float*)a->in[k]; }
DI const int* inI(CArgsP a, int k) { return (const int*)(GAS1 const int*)a->in[k]; }
DI float* outF(CArgsP a) { return (float*)(GAS1 float*)a->out; }
DI unsigned char* wsG(CArgsP a) { return (unsigned char*)(GAS1 unsigned char*)a->ws; }

DI int qkperm(int d) { return 32 * ((d >> 4) & 3) + 8 * ((d >> 2) & 3) + 4 * (d >> 6) + (d & 3); }
DI int map_in(int n) {
    if (n < 2048) return n;
    if (n < 3584) { const int e = n - 2048; return 4096 + (e & ~127) + qkperm(e & 127); }
    if (n < 5120) { const int e = n - 3584; return 5632 + (e & ~127) + qkperm(e & 127); }
    if (n < 6656) return 7168 + (n - 5120);
    return 2048 + (n - 6656);
}
DI void transpose_item(const float* W, int K, int N, bf16_t* WT, const float* gk, int mapkind, LAS float* scr, int item, int lane) {
    const int nblk = N / 32, kb = item / nblk, nb = item % nblk, k0 = 64 * kb, n0 = 32 * nb;
    float wv[32];
    const float* wp = W + (size_t)(k0 + (lane >> 5)) * N + n0 + (lane & 31);
#pragma unroll
    for (int i = 0; i < 32; ++i) wv[i] = __builtin_nontemporal_load(wp + (size_t)(2 * i) * N);
    if (gk) {
        const float* gp = gk + k0 + (lane >> 5);
#pragma unroll
        for (int i = 0; i < 32; ++i) wv[i] *= gp[2 * i]; }
#pragma unroll
    for (int i = 0; i < 32; ++i) scr[(2 * i + (lane >> 5)) * 33 + (lane & 31)] = wv[i];
    LDS_WAIT(); asm volatile("" ::: "memory");
    const int c = lane & 7;
#pragma unroll
    for (int j = 0; j < 4; ++j) { const int n = (lane >> 3) + 8 * j; const LAS float* s = scr + (8 * c) * 33 + n;
        u32x4 o; o.x = pk2(s[0 * 33], s[1 * 33]); o.y = pk2(s[2 * 33], s[3 * 33]); o.z = pk2(s[4 * 33], s[5 * 33]); o.w = pk2(s[6 * 33], s[7 * 33]);
        const int dst = mapkind ? map_in(n0 + n) : (n0 + n);
        *(u32x4*)(WT + (size_t)dst * K + k0 + 8 * c) = o; }
    LDS_WAIT(); asm volatile("" ::: "memory");
}
DI void convert_weights(CArgsP a, int l, int mask, LAS unsigned char* lds, int gw, int NGW, int wave, int lane) {
    LAS float* scr = (LAS float*)(lds + wave * 8448);
    unsigned char* ws = wsG(a);
    constexpr int I_IN = 16 * 272, I_LRU = 8 * 8, I_DN = 48 * 32, I_PR = 16 * 32, I_PA = 8 * 32, I_WO = 16 * 32, I_UP = 16 * 192;
    const int total = ((mask & 1) ? I_IN : 0) + ((mask & 2) ? 2 * I_LRU : 0) + ((mask & 4) ? I_DN : 0) + ((mask & 8) ? (I_PR + I_PA + I_WO + I_UP) : 0);
    for (int it = gw; it < total; it += NGW) {
        int r = it;
        if (mask & 1) { if (r < I_IN) { transpose_item(inF(a, 3) + (size_t)l * DM * NIN, DM, NIN, (bf16_t*)(ws + WS_W1T), inF(a, 2) + l * DM, 1, scr, r, lane); continue; } r -= I_IN; }
        if (mask & 2) {
            if (r < I_LRU) { const int blk = r >> 3; transpose_item(inF(a, 6) + (size_t)l * 131072 + blk * 16384, 128, 128, (bf16_t*)(ws + WS_WAT) + blk * 16384, nullptr, 0, scr, r & 7, lane); continue; } r -= I_LRU;
            if (r < I_LRU) { const int blk = r >> 3; transpose_item(inF(a, 8) + (size_t)l * 131072 + blk * 16384, 128, 128, (bf16_t*)(ws + WS_WXT) + blk * 16384, nullptr, 0, scr, r & 7, lane); continue; } r -= I_LRU; }
        if (mask & 4) { if (r < I_DN) { transpose_item(inF(a, 20) + (size_t)l * DFF * DM, DFF, DM, (bf16_t*)(ws + WS_WDT), nullptr, 0, scr, r, lane); continue; } r -= I_DN; }
        if (mask & 8) {
            if (r < I_PR) { transpose_item(inF(a, 13) + (size_t)l * DM * DM, DM, DM, (bf16_t*)(ws + WS_PRT), nullptr, 0, scr, r, lane); continue; } r -= I_PR;
            if (r < I_PA) { transpose_item(inF(a, 14) + (size_t)l * 512 * DM, 512, DM, (bf16_t*)(ws + WS_PAT), nullptr, 0, scr, r, lane); continue; } r -= I_PA;
            if (r < I_WO) { transpose_item(inF(a, 15) + (size_t)l * DM * DM, DM, DM, (bf16_t*)(ws + WS_WOT), nullptr, 0, scr, r, lane); continue; } r -= I_WO;
            transpose_item(inF(a, 17) + (size_t)l * DM * NUP, DM, NUP, (bf16_t*)(ws + WS_WUT), inF(a, 16) + l * DM, 0, scr, r, lane); }
    }
}

DI void p0_rows(CArgsP a, int gw, int NGW, int lane) {
    const float* x = inF(a, 0); bf16_t* XB = (bf16_t*)(wsG(a) + WS_XB); float* ssp = (float*)(wsG(a) + WS_SSP);
    for (int m0 = 2 * gw; m0 < T; m0 += 2 * NGW) {
        const f32x4* xr0 = (const f32x4*)(x + (size_t)m0 * DM) + lane; const f32x4* xr1 = xr0 + DM / 4; f32x4 v[2][4]; float s0 = 0.f, s1 = 0.f;
#pragma unroll
        for (int j = 0; j < 4; ++j) { v[0][j] = __builtin_nontemporal_load(xr0 + 64 * j); v[1][j] = __builtin_nontemporal_load(xr1 + 64 * j); }
#pragma unroll
        for (int j = 0; j < 4; ++j) { s0 += (v[0][j].x * v[0][j].x + v[0][j].y * v[0][j].y) + (v[0][j].z * v[0][j].z + v[0][j].w * v[0][j].w);
                                      s1 += (v[1][j].x * v[1][j].x + v[1][j].y * v[1][j].y) + (v[1][j].z * v[1][j].z + v[1][j].w * v[1][j].w); }
#pragma unroll
        for (int o = 1; o < 64; o <<= 1) { s0 += __shfl_xor(s0, o); s1 += __shfl_xor(s1, o); }
        u32x2* o0 = (u32x2*)(XB + (size_t)m0 * DM) + lane; u32x2* o1 = o0 + DM / 4;
#pragma unroll
        for (int j = 0; j < 4; ++j) { u32x2 w; w.x = pk2(v[0][j].x, v[0][j].y); w.y = pk2(v[0][j].z, v[0][j].w); o0[64 * j] = w;
                                      u32x2 w1; w1.x = pk2(v[1][j].x, v[1][j].y); w1.y = pk2(v[1][j].z, v[1][j].w); o1[64 * j] = w1; }
        if (lane < 16) ssp[(size_t)m0 * 16 + lane] = (lane == 0) ? s0 : 0.f;
        else if (lane < 32) ssp[(size_t)(m0 + 1) * 16 + (lane - 16)] = (lane == 16) ? s1 : 0.f;
    }
}
DI void p0_rope(CArgsP a, int gtid, int nthr) {
    const int* pos = inI(a, 1); float* cosT = (float*)(wsG(a) + WS_COS); float* sinT = (float*)(wsG(a) + WS_SIN);
    for (int i = gtid; i < T * 64; i += nthr) {
        const int t = i >> 6, f = i & 63;
        const float inv = exp2f(-(float)f * (13.287712379549449f / 64.0f));
        const float ang = (float)pos[t] * inv;
        const double ad = (double)ang; const double kk = __builtin_rint(ad * 0.15915494309189535); const float r = (float)(ad - kk * 6.283185307179586);
        cosT[i] = __cosf(r); sinT[i] = __sinf(r);
    }
}

#define MFMA32(a, b, c) __builtin_amdgcn_mfma_f32_32x32x16_bf16((a), (b), (c), 0, 0, 0)
DI void lru_phase(CArgsP a, int l, LAS unsigned char* lds, int G, int tid, int wave, int lane) {
    unsigned char* ws = wsG(a);
    const bf16_t* XR = (const bf16_t*)(ws + WS_AR + AR_XR);
    LAS unsigned char* XCb = lds;
    LAS float* XCF = (LAS float*)(lds + 17408);
    LAS float* AA = (LAS float*)(lds + 17408 + 32768);
    const int cg8 = tid & 15, tr = tid >> 4;
    const int r = lane & 31, h = lane >> 5;
    const int cl = 16 * wave + (r & 15); const bool isI = r >= 16;
    int cur_n = -1;
    float w[4][8], bb[8]; bf16x8 bfr[8]; float bias = 0.f, sp8 = 0.f;
    unsigned long long pt0 = 0, pt1 = 0, pt2 = 0, pt3 = 0, pa0 = 0, pa1 = 0, pa2 = 0;
    u32x4 xv[2][4];
#define LRU_LOAD_XR(IT) do { const int b_ = (IT) >> 8, n_ = ((IT) >> 5) & 7, ck_ = (IT) & 31; const int c_ = n_ * 128 + 8 * cg8; \
        _Pragma("unroll") for (int j = 0; j < 2; ++j) _Pragma("unroll") for (int i = 0; i < 4; ++i) { const int p = ck_ * 64 + tr + 32 * j - 3 + i; \
            xv[j][i] = *(const u32x4*)(XR + (size_t)(b_ * SEQ + (p < 0 ? 0 : p)) * DM + c_); } } while (0)
    if ((int)blockIdx.x < 2048) LRU_LOAD_XR((int)blockIdx.x);
    for (int item = blockIdx.x; item < 2048; item += G) {
        const int b = item >> 8, n = (item >> 5) & 7, ck = item & 31;
        const int t0 = b * SEQ + ck * 64, c0 = n * 128;
        if (n != cur_n) {
            cur_n = n;
            const int c = c0 + 8 * cg8;
            const float* cw = inF(a, 4) + (size_t)l * 4 * DM + c; const float* cb = inF(a, 5) + (size_t)l * DM + c;
#pragma unroll
            for (int i = 0; i < 4; ++i) { const f32x4 w0 = *(const f32x4*)(cw + i * DM), w1 = *(const f32x4*)(cw + i * DM + 4);
#pragma unroll
                for (int e = 0; e < 4; ++e) { w[i][e] = w0[e]; w[i][4 + e] = w1[e]; } }
            { const f32x4 b0 = *(const f32x4*)cb, b1 = *(const f32x4*)(cb + 4);
#pragma unroll
              for (int e = 0; e < 4; ++e) { bb[e] = b0[e]; bb[4 + e] = b1[e]; } }
            const bf16_t* wrow = (r < 16) ? (const bf16_t*)(ws + WS_WAT) + n * 16384 + (16 * wave + r) * 128 : (const bf16_t*)(ws + WS_WXT) + n * 16384 + (16 * wave + r - 16) * 128;
#pragma unroll
            for (int ks = 0; ks < 8; ++ks) bfr[ks] = *(const bf16x8*)(wrow + 16 * ks + 8 * h);
            bias = isI ? (inF(a, 9))[(size_t)l * DM + c0 + cl] : (inF(a, 7))[(size_t)l * DM + c0 + cl];
            const float lam = (inF(a, 10))[(size_t)l * DM + c0 + cl];
            sp8 = 8.0f * log1pf(expf(-lam));
        }
        if (PROBE_SEL >= 0) pt0 = __builtin_amdgcn_s_memrealtime();
        {
#pragma unroll
            for (int j = 0; j < 2; ++j) { const int tl = tr + 32 * j, tp = ck * 64 + tl; float o[8];
#pragma unroll
                for (int e = 0; e < 8; ++e) o[e] = bb[e];
#pragma unroll
                for (int i = 0; i < 4; ++i) { const int p = tp - 3 + i; const float z = (p >= 0) ? 1.0f : 0.0f; const u32x4 v = xv[j][i];
                    o[0] += z * w[i][0] * bflo(v.x); o[1] += z * w[i][1] * bfhi(v.x); o[2] += z * w[i][2] * bflo(v.y); o[3] += z * w[i][3] * bfhi(v.y);
                    o[4] += z * w[i][4] * bflo(v.z); o[5] += z * w[i][5] * bfhi(v.z); o[6] += z * w[i][6] * bflo(v.w); o[7] += z * w[i][7] * bfhi(v.w); }
                *(LAS f32x4*)(XCF + tl * 128 + 8 * cg8) = (f32x4){o[0], o[1], o[2], o[3]}; *(LAS f32x4*)(XCF + tl * 128 + 8 * cg8 + 4) = (f32x4){o[4], o[5], o[6], o[7]};
                u32x4 pw; pw.x = pk2(o[0], o[1]); pw.y = pk2(o[2], o[3]); pw.z = pk2(o[4], o[5]); pw.w = pk2(o[6], o[7]);
                *(LAS u32x4*)(XCb + tl * 272 + 16 * cg8) = pw; }
            if (item + G < 2048) LRU_LOAD_XR(item + G);
        }
        __syncthreads();
        if (PROBE_SEL >= 0) pt1 = __builtin_amdgcn_s_memrealtime();
#pragma unroll
        for (int rt = 0; rt < 2; ++rt) {
            f32x16 acc;
#pragma unroll
            for (int i = 0; i < 16; ++i) acc[i] = 0.f;
#pragma unroll
            for (int ks = 0; ks < 8; ++ks) { const bf16x8 af = *(const LAS bf16x8*)(XCb + (32 * rt + r) * 272 + (16 * ks + 8 * h) * 2); acc = MFMA32(af, bfr[ks], acc); }
#pragma unroll
            for (int k = 0; k < 8; ++k) {
                const float g0 = sigmoidf_(acc[2 * k] + bias), g1 = sigmoidf_(acc[2 * k + 1] + bias);
                const float o0 = __shfl_xor(g0, 16), o1 = __shfl_xor(g1, 16);
                const float mine = isI ? g1 : g0, oth = isI ? o1 : o0;
                const float rg = isI ? oth : mine, ig = isI ? mine : oth;
                const int tl = 32 * rt + ((2 * k) & 3) + 8 * ((2 * k) >> 2) + 4 * h + (isI ? 1 : 0);
                const float la = -sp8 * rg;
                const float xv1 = XCF[tl * 128 + cl];
                AA[tl * 128 + cl] = fexp(la);
                XCF[tl * 128 + cl] = __builtin_amdgcn_sqrtf(one_minus_exp(2.0f * la)) * (ig * xv1); }
        }
        __syncthreads();
        if (PROBE_SEL >= 0) pt2 = __builtin_amdgcn_s_memrealtime();
        if (wave < 4) {
            const int cs = 32 * wave + (lane & 31), sg = lane >> 5; const int tb = 32 * sg;
            float A = 1.f, H = 0.f;
#pragma unroll 8
            for (int s2 = 0; s2 < 32; ++s2) { const float av = AA[(tb + s2) * 128 + cs], uv = XCF[(tb + s2) * 128 + cs]; H = av * H + uv; A *= av; }
            const float A0 = __shfl(A, lane & 31), H0 = __shfl(H, lane & 31);
            float hh = sg ? H0 : 0.f, Ac = sg ? A0 : 1.f;
            unsigned* HL = (unsigned*)(ws + WS_AR + AR_HL) + (size_t)(t0 + tb) * DM + c0 + cs;
#pragma unroll 8
            for (int s2 = 0; s2 < 32; ++s2) { const float av = AA[(tb + s2) * 128 + cs], uv = XCF[(tb + s2) * 128 + cs]; hh = av * hh + uv; Ac *= av; __builtin_nontemporal_store(pkh2(hh, Ac), HL + (size_t)s2 * DM); }
            if (sg) { ((float*)(ws + WS_AGGA))[(size_t)(b * 32 + ck) * DM + c0 + cs] = Ac; ((float*)(ws + WS_AGGH))[(size_t)(b * 32 + ck) * DM + c0 + cs] = hh; }
        }
        __syncthreads();
        if (PROBE_SEL >= 0) { pt3 = __builtin_amdgcn_s_memrealtime(); pa0 += pt1 - pt0; pa1 += pt2 - pt1; pa2 += pt3 - pt2; }
    }
    if (PROBE_SEL >= 0 && blockIdx.x == 0 && tid == 0) { unsigned long long* TSP = (unsigned long long*)(ws + WS_CTL + 512 * 1024); TSP[96] += pa0; TSP[97] += pa1; TSP[98] += pa2; }
}

DI bf16x8 pack8(const f32x16& x, int s) {
    u32x4 p; p.x = pk2(x[8 * s], x[8 * s + 1]); p.y = pk2(x[8 * s + 2], x[8 * s + 3]); p.z = pk2(x[8 * s + 4], x[8 * s + 5]); p.w = pk2(x[8 * s + 6], x[8 * s + 7]);
    return __builtin_bit_cast(bf16x8, p);
}
DI void attn_item(unsigned char* ws, LAS unsigned char* wl  , int hd, int b, int qi, int qi0  , int lane) {
    const bf16_t* Q = (const bf16_t*)(ws + WS_AR + AR_Q); const bf16_t* Kp = (const bf16_t*)(ws + WS_AR + AR_K); const bf16_t* V = (const bf16_t*)(ws + WS_AR + AR_V);
    bf16_t* OG = (bf16_t*)(ws + WS_AR + AR_OG); float* LSE = (float*)(ws + WS_LSE);
    const int sh = 2 * (hd >> 2), tps = 64 >> sh;
    const int rstream = qi / tps, m0 = 32 * (qi % tps);
    const int r = lane & 31, h = lane >> 5;
    const int lrow = lane >> 4, lch = lane & 15;
    LAS unsigned char* KL = wl; LAS unsigned char* VL = wl + 8704;
    const size_t qtok = (size_t)b * SEQ + ((size_t)(m0 + r) << sh) + rstream;
    const int kt0 = (m0 >= 128) ? 0 : (4 - (m0 >> 5));
    const size_t tstride = ((size_t)32 << sh) * AW, rstride = ((size_t)4 << sh) * AW;
    const size_t stok0 = (size_t)b * SEQ + ((size_t)(m0 - 128 + 32 * kt0 + lrow) << sh) + rstream;
    const bf16_t* kg = Kp + stok0 * AW + hd * 128 + 8 * lch; const bf16_t* vg = V + stok0 * AW + hd * 128 + 8 * lch;
    u32x4 ks_[8], vs_[8];
#pragma unroll
    for (int i = 0; i < 8; ++i) ks_[i] = *(const u32x4*)(kg + (size_t)i * rstride);
#pragma unroll
    for (int i = 0; i < 8; ++i) vs_[i] = *(const u32x4*)(vg + (size_t)i * rstride);
    const bf16_t* qrow = Q + qtok * AW + hd * 128 + 8 * h;
    bf16x8 qf[8];
#pragma unroll
    for (int ks = 0; ks < 8; ++ks) qf[ks] = *(const bf16x8*)(qrow + 16 * ks);
    bf16x8 idf[2];
#pragma unroll
    for (int e = 0; e < 2; ++e)
#pragma unroll
        for (int j = 0; j < 8; ++j) idf[e][j] = (16 * e + 8 * h + j == r) ? (short)0x3F80 : (short)0;
    f32x16 O[4];
#pragma unroll
    for (int dt = 0; dt < 4; ++dt)
#pragma unroll
        for (int i = 0; i < 16; ++i) O[dt][i] = 0.f;
    float mrun = -1e30f, lpart = 0.f;
    constexpr float L2E = 1.4426950408889634f;
    const int woff = lrow * 272 + lch * 16, roff = r * 272 + h * 16;
    const int trb = (4 * h + ((lane & 15) >> 2)) * 272 + (16 * (r >> 4) + 4 * (lane & 3)) * 2;
    const int dq = 0, nsteps = 5; (void)qi0;
    for (int st = 0; st < nsteps; ++st) {
        const int kt = st + dq;
        if (kt >= kt0 && kt < 5) {
#pragma unroll
        for (int i = 0; i < 8; ++i) { *(LAS u32x4*)(KL + woff + i * 1088) = ks_[i]; *(LAS u32x4*)(VL + woff + i * 1088) = vs_[i]; }
        if (kt < 4) { kg += tstride; vg += tstride;
#pragma unroll
            for (int i = 0; i < 8; ++i) ks_[i] = *(const u32x4*)(kg + (size_t)i * rstride);
#pragma unroll
            for (int i = 0; i < 8; ++i) vs_[i] = *(const u32x4*)(vg + (size_t)i * rstride); }
        f32x16 Sx;
#pragma unroll
        for (int i = 0; i < 16; ++i) Sx[i] = 0.f;
#pragma unroll
        for (int ks = 0; ks < 8; ++ks) { const bf16x8 kf = *(const LAS bf16x8*)(KL + roff + 32 * ks); Sx = MFMA32(kf, qf[ks], Sx); }
        float mx = -1e30f;
        if (kt == 0 || kt == 4) {
#pragma unroll
            for (int i = 0; i < 16; ++i) { const int ki = (i & 3) + 8 * (i >> 2) + 4 * h;
                if ((kt == 0 && ki < r) || (kt == 4 && ki > r)) Sx[i] = -1e30f; } }
#pragma unroll
        for (int i = 0; i < 16; ++i) mx = fmaxf(mx, Sx[i]);
        mx = fmaxf(mx, __shfl_xor(mx, 32));
        const float mnew = fmaxf(mrun, mx), alpha = __builtin_amdgcn_exp2f((mrun - mnew) * L2E);
        float ps = 0.f;
#pragma unroll
        for (int i = 0; i < 16; ++i) { Sx[i] = __builtin_amdgcn_exp2f((Sx[i] - mnew) * L2E); ps += Sx[i]; }
        const bool any_grow = __builtin_amdgcn_ballot_w64(mnew > mrun) != 0ull;
        lpart = lpart * alpha + ps; mrun = mnew;
        const bf16x8 pf0 = pack8(Sx, 0), pf1 = pack8(Sx, 1);
#pragma unroll
        for (int dt = 0; dt < 4; ++dt) {
            const LAS unsigned char* tb = VL + trb + 64 * dt;
            const s16x4 a00 = __builtin_amdgcn_ds_read_tr16_b64_v4i16((LAS s16x4*)(tb)), a01 = __builtin_amdgcn_ds_read_tr16_b64_v4i16((LAS s16x4*)(tb + 8 * 272));
            const s16x4 a10 = __builtin_amdgcn_ds_read_tr16_b64_v4i16((LAS s16x4*)(tb + 16 * 272)), a11 = __builtin_amdgcn_ds_read_tr16_b64_v4i16((LAS s16x4*)(tb + 24 * 272));
            const bf16x8 xf0 = __builtin_shufflevector(a00, a01, 0, 1, 2, 3, 4, 5, 6, 7), xf1 = __builtin_shufflevector(a10, a11, 0, 1, 2, 3, 4, 5, 6, 7);
            if (any_grow) {
#pragma unroll
            for (int i = 0; i < 16; ++i) O[dt][i] *= alpha; }
            O[dt] = MFMA32(xf0, pf0, O[dt]); O[dt] = MFMA32(xf1, pf1, O[dt]);
        }
        }
        __builtin_amdgcn_s_barrier();
    }
    const float ltot = lpart + __shfl_xor(lpart, 32), inv = frcp(ltot);
    bf16_t* orow = OG + qtok * AW + hd * 128 + 4 * h;
#pragma unroll
    for (int dt = 0; dt < 4; ++dt)
#pragma unroll
        for (int gq = 0; gq < 4; ++gq) { u32x2 w; w.x = pk2(O[dt][4 * gq] * inv, O[dt][4 * gq + 1] * inv); w.y = pk2(O[dt][4 * gq + 2] * inv, O[dt][4 * gq + 3] * inv);
            *(u32x2*)(orow + 32 * dt + 8 * gq) = w; }
    if (h == 0) LSE[qtok * 12 + hd] = mrun + logf(ltot);
}

DI void b2_fix(CArgsP a, int tid) {
    unsigned char* ws = wsG(a);
    const float* AGA = (const float*)(ws + WS_AGGA); const float* AGH = (const float*)(ws + WS_AGGH);
    const unsigned* HL = (const unsigned*)(ws + WS_AR + AR_HL); const bf16_t* GG = (const bf16_t*)(ws + WS_AR + AR_GG); bf16_t* YR = (bf16_t*)(ws + WS_AR + AR_YR);
    for (int it = blockIdx.x; it < 256; it += gridDim.x) {
        const int b = it >> 5, ck = it & 31, c = 4 * (tid & 255), th = tid >> 8;
        f32x4 carry = {0.f, 0.f, 0.f, 0.f};
        {
            const float* pa = AGA + (size_t)(b * 32) * DM + c; const float* ph = AGH + (size_t)(b * 32) * DM + c;
            int j = 0;
            for (; j + 8 <= ck; j += 8) { f32x4 A[8], H[8];
#pragma unroll
                for (int e = 0; e < 8; ++e) { A[e] = *(const f32x4*)(pa + (size_t)(j + e) * DM); H[e] = *(const f32x4*)(ph + (size_t)(j + e) * DM); }
#pragma unroll
                for (int e = 0; e < 8; ++e) carry = A[e] * carry + H[e]; }
            for (; j < ck; ++j) { const f32x4 A = *(const f32x4*)(pa + (size_t)j * DM), H = *(const f32x4*)(ph + (size_t)j * DM); carry = A * carry + H; }
        }
        const size_t tb = (size_t)b * SEQ + ck * 64 + 32 * th;
#pragma unroll 4
        for (int s = 0; s < 32; ++s) { const size_t off = (tb + s) * DM + c;
            const u32x4 hl = __builtin_nontemporal_load((const u32x4*)(HL + off)); const u32x2 gg = __builtin_nontemporal_load((const u32x2*)(GG + off));
            const float y0 = (hlo(hl.x) + hhi(hl.x) * carry[0]) * bflo(gg.x), y1 = (hlo(hl.y) + hhi(hl.y) * carry[1]) * bfhi(gg.x);
            const float y2 = (hlo(hl.z) + hhi(hl.z) * carry[2]) * bflo(gg.y), y3 = (hlo(hl.w) + hhi(hl.w) * carry[3]) * bfhi(gg.y);
            u32x2 w; w.x = pk2(y0, y1); w.y = pk2(y2, y3); *(u32x2*)(YR + off) = w; }
    }
}
DI void b2_merge(unsigned char* ws, int gtid, int nthr) {
    const bf16_t* OG = (const bf16_t*)(ws + WS_AR + AR_OG); const float* LSE = (const float*)(ws + WS_LSE); bf16_t* YA = (bf16_t*)(ws + WS_AR + AR_YA);
#pragma unroll 2
    for (int i = gtid; i < T * 64; i += nthr) {
        const int t = i >> 6, j = (i >> 4) & 3, d8 = i & 15;
        const float l0 = LSE[(size_t)t * 12 + j], l1 = LSE[(size_t)t * 12 + 4 + j], l2 = LSE[(size_t)t * 12 + 8 + j];
        const float mx = fmaxf(l0, fmaxf(l1, l2)); const float e0 = fexp(l0 - mx), e1 = fexp(l1 - mx), e2 = fexp(l2 - mx); const float inv = frcp(e0 + e1 + e2);
        const float w0 = e0 * inv, w1 = e1 * inv, w2 = e2 * inv;
        const bf16_t* op = OG + (size_t)t * AW + j * 128 + 8 * d8;
        const u32x4 o0 = __builtin_nontemporal_load((const u32x4*)op), o1 = __builtin_nontemporal_load((const u32x4*)(op + 512)), o2 = __builtin_nontemporal_load((const u32x4*)(op + 1024));
        u32x4 w;
        w.x = pk2(w0 * bflo(o0.x) + w1 * bflo(o1.x) + w2 * bflo(o2.x), w0 * bfhi(o0.x) + w1 * bfhi(o1.x) + w2 * bfhi(o2.x));
        w.y = pk2(w0 * bflo(o0.y) + w1 * bflo(o1.y) + w2 * bflo(o2.y), w0 * bfhi(o0.y) + w1 * bfhi(o1.y) + w2 * bfhi(o2.y));
        w.z = pk2(w0 * bflo(o0.z) + w1 * bflo(o1.z) + w2 * bflo(o2.z), w0 * bfhi(o0.z) + w1 * bfhi(o1.z) + w2 * bfhi(o2.z));
        w.w = pk2(w0 * bflo(o0.w) + w1 * bflo(o1.w) + w2 * bflo(o2.w), w0 * bfhi(o0.w) + w1 * bfhi(o1.w) + w2 * bfhi(o2.w));
        *(u32x4*)(YA + (size_t)t * 512 + j * 128 + 8 * d8) = w;
    }
}

DI void e2_convact(CArgsP a, int l, int gtid, int nthr) {
    unsigned char* ws = wsG(a);
    const bf16_t* U = (const bf16_t*)(ws + WS_AR + AR_U); bf16_t* ACT = (bf16_t*)(ws + WS_AR + AR_ACT);
    const float* cw = inF(a, 18) + (size_t)l * 3 * NUP; const float* cb = inF(a, 19) + (size_t)l * NUP;
    for (int i = gtid; i < 1024 * 384; i += nthr) {
        const int c8 = i % 384, run = i / 384, c = 8 * c8; const int tstart = run * 16, p0 = tstart & (SEQ - 1);
        float wg[3][8], wv[3][8], bg[8], bv[8];
#pragma unroll
        for (int k = 0; k < 3; ++k) { const f32x4 g0 = *(const f32x4*)(cw + k * NUP + c), g1 = *(const f32x4*)(cw + k * NUP + c + 4), v0 = *(const f32x4*)(cw + k * NUP + DFF + c), v1 = *(const f32x4*)(cw + k * NUP + DFF + c + 4);
#pragma unroll
            for (int e = 0; e < 4; ++e) { wg[k][e] = g0[e]; wg[k][4 + e] = g1[e]; wv[k][e] = v0[e]; wv[k][4 + e] = v1[e]; } }
        { const f32x4 g0 = *(const f32x4*)(cb + c), g1 = *(const f32x4*)(cb + c + 4), v0 = *(const f32x4*)(cb + DFF + c), v1 = *(const f32x4*)(cb + DFF + c + 4);
#pragma unroll
          for (int e = 0; e < 4; ++e) { bg[e] = g0[e]; bg[4 + e] = g1[e]; bv[e] = v0[e]; bv[4 + e] = v1[e]; } }
        float g2[8], g1r[8], v2[8], v1r[8];
#pragma unroll
        for (int e = 0; e < 8; ++e) { g2[e] = 0.f; g1r[e] = 0.f; v2[e] = 0.f; v1r[e] = 0.f; }
        if (p0 >= 2) {
            const u32x4 ga = *(const u32x4*)(U + (size_t)(tstart - 2) * NUP + c), gb = *(const u32x4*)(U + (size_t)(tstart - 1) * NUP + c);
            const u32x4 va = *(const u32x4*)(U + (size_t)(tstart - 2) * NUP + DFF + c), vb = *(const u32x4*)(U + (size_t)(tstart - 1) * NUP + DFF + c);
            g2[0] = bflo(ga.x); g2[1] = bfhi(ga.x); g2[2] = bflo(ga.y); g2[3] = bfhi(ga.y); g2[4] = bflo(ga.z); g2[5] = bfhi(ga.z); g2[6] = bflo(ga.w); g2[7] = bfhi(ga.w);
            g1r[0] = bflo(gb.x); g1r[1] = bfhi(gb.x); g1r[2] = bflo(gb.y); g1r[3] = bfhi(gb.y); g1r[4] = bflo(gb.z); g1r[5] = bfhi(gb.z); g1r[6] = bflo(gb.w); g1r[7] = bfhi(gb.w);
            v2[0] = bflo(va.x); v2[1] = bfhi(va.x); v2[2] = bflo(va.y); v2[3] = bfhi(va.y); v2[4] = bflo(va.z); v2[5] = bfhi(va.z); v2[6] = bflo(va.w); v2[7] = bfhi(va.w);
            v1r[0] = bflo(vb.x); v1r[1] = bfhi(vb.x); v1r[2] = bflo(vb.y); v1r[3] = bfhi(vb.y); v1r[4] = bflo(vb.z); v1r[5] = bfhi(vb.z); v1r[6] = bflo(vb.w); v1r[7] = bfhi(vb.w);
        }
#pragma unroll 4
        for (int s = 0; s < 16; ++s) {
            const u32x4 gc = __builtin_nontemporal_load((const u32x4*)(U + (size_t)(tstart + s) * NUP + c)), vc = __builtin_nontemporal_load((const u32x4*)(U + (size_t)(tstart + s) * NUP + DFF + c));
            float g0[8], v0[8];
            g0[0] = bflo(gc.x); g0[1] = bfhi(gc.x); g0[2] = bflo(gc.y); g0[3] = bfhi(gc.y); g0[4] = bflo(gc.z); g0[5] = bfhi(gc.z); g0[6] = bflo(gc.w); g0[7] = bfhi(gc.w);
            v0[0] = bflo(vc.x); v0[1] = bfhi(vc.x); v0[2] = bflo(vc.y); v0[3] = bfhi(vc.y); v0[4] = bflo(vc.z); v0[5] = bfhi(vc.z); v0[6] = bflo(vc.w); v0[7] = bfhi(vc.w);
            float o[8];
#pragma unroll
            for (int e = 0; e < 8; ++e) { const float ug = bg[e] + wg[0][e] * g2[e] + wg[1][e] * g1r[e] + wg[2][e] * g0[e]; const float uv = bv[e] + wv[0][e] * v2[e] + wv[1][e] * v1r[e] + wv[2][e] * v0[e];
                o[e] = gelu_tanh(ug) * uv; g2[e] = g1r[e]; g1r[e] = g0[e]; v2[e] = v1r[e]; v1r[e] = v0[e]; }
            u32x4 w; w.x = pk2(o[0], o[1]); w.y = pk2(o[2], o[3]); w.z = pk2(o[4], o[5]); w.w = pk2(o[6], o[7]);
            *(u32x4*)(ACT + (size_t)(tstart + s) * DFF + c) = w;
        }
    }
}

constexpr int NPHASE = 1 + 8 * DEPTH;
__global__ void __launch_bounds__(512, 2) mega(Args a_byval) {
    CArgsP a0 = (CArgsP)__builtin_amdgcn_kernarg_segment_ptr(); CArgsP a = a0;
    extern __shared__ __attribute__((aligned(16))) unsigned char lds_raw[];
    LAS unsigned char* lds = (LAS unsigned char*)lds_raw;
    unsigned char* ws0 = wsG(a);
    volatile LAS unsigned* MISC = (volatile LAS unsigned*)(lds + MISC_OFF);
    if (threadIdx.x < 64) MISC[threadIdx.x] = 0u;
    __syncthreads();
    XcdBarrier bar; bar.bar = (unsigned*)(ws0 + WS_CTL); bar.x = 0; bar.st = MISC + 8;
    if (a->coop && !USE_CG_SYNC) bar = xcd_barrier_post((unsigned*)(ws0 + WS_CTL), MISC + 8);

    unsigned long long* TS = (unsigned long long*)(ws0 + WS_CTL + 512 * 1024);
    if (PROBE_SEL >= 0 && blockIdx.x == 0 && threadIdx.x == 0) TS[0] = __builtin_amdgcn_s_memrealtime();
    for (int ph = a->ph_lo; ph < a->ph_hi; ++ph) {
        a = a0; asm volatile("" : "+s"(a));
        GAS1 unsigned char* wsg = (GAS1 unsigned char*)a->ws; asm volatile("" : "+s"(wsg)); unsigned char* ws = (unsigned char*)wsg;
        int bid = blockIdx.x; asm volatile("" : "+s"(bid));
        int G = gridDim.x; asm volatile("" : "+s"(G));
        const int NGW = G * 8, nthr = G * 512;
        int tid = threadIdx.x; asm volatile("" : "+v"(tid));
        const int lane = tid & 63, wave = __builtin_amdgcn_readfirstlane(tid >> 6);
        const int gw = bid * 8 + wave, gtid = bid * 512 + tid;
        if (ph == 0) {
          if (PHASE_MASK & 1) {
            convert_weights(a, 0, (G == 256) ? 7 : 15, lds, gw, NGW, wave, lane);
            p0_rows(a, gw, NGW, lane);
            p0_rope(a, gtid, nthr);
          }
        } else {
            const int l = (ph - 1) >> 3, sub = (ph - 1) & 7;
            float* xout = outF(a);
            bf16_t* XB = (bf16_t*)(ws + WS_XB); float* ssp = (float*)(ws + WS_SSP);
            if (sub == 0 && (PHASE_MASK & 2)) {
                pg8::Gemm g{XB, (const bf16_t*)(ws + WS_W1T), T, NIN, DM}; pg8::StaticOrder S; S.init(T, NIN, G, bid);
                pg8::EpiIn E{ssp, (bf16_t*)(ws + WS_AR + AR_XR), (bf16_t*)(ws + WS_AR + AR_GG), (bf16_t*)(ws + WS_AR + AR_SGR), (bf16_t*)(ws + WS_AR + AR_SGA),
                             (bf16_t*)(ws + WS_AR + AR_Q), (bf16_t*)(ws + WS_AR + AR_K), (bf16_t*)(ws + WS_AR + AR_V),
                             inF(a, 11) + (size_t)l * AW, inF(a, 12) + (size_t)l * AW, (const float*)(ws + WS_COS), (const float*)(ws + WS_SIN), (LAS float*)(lds + TAB_OFF)};
                pg8::gemm_phase(lds, g, S, E);
                if (G == 256 && bid >= 128) convert_weights(a, l, 8, lds, (bid - 128) * 8 + wave, 128 * 8, wave, lane);
            } else if (sub == 1 && (PHASE_MASK & 4)) {
                const bool attn_first = ((bid >> 3) & 1) != 0;
                if (!attn_first) lru_phase(a, l, lds, G, tid, wave, lane);
                unsigned long long tp0 = 0, tp1 = 0;
                if (PROBE_SEL >= 0) { __syncthreads(); tp0 = __builtin_amdgcn_s_memrealtime(); if (threadIdx.x == 0) { atomicMax((unsigned*)(TS + 80 + l), (unsigned)(tp0 - TS[1 + 8 * l + 1])); if (blockIdx.x == 0) TS[64 + l] = tp0; } }
                for (int u = bid; u < 768; u += G) attn_item(ws, lds + wave * 17408, u >> 6, (u >> 3) & 7, 8 * (u & 7) + wave, 8 * (u & 7), lane);
                if (attn_first) { __syncthreads(); lru_phase(a, l, lds, G, tid, wave, lane); }
                if (PROBE_SEL >= 0) { __syncthreads(); tp1 = __builtin_amdgcn_s_memrealtime(); if (threadIdx.x == 0) { atomicMax((unsigned*)(TS + 88 + l), (unsigned)(tp1 - tp0)); if (blockIdx.x == 0) TS[72 + l] = tp1; } }
            } else if (sub == 2 && (PHASE_MASK & 8)) {
                b2_fix(a, tid);
                b2_merge(ws, gtid, nthr);
                if (l + 1 < DEPTH) convert_weights(a, l + 1, 3, lds, gw, NGW, wave, lane);
                if (l >= 1) convert_weights(a, l, 4, lds, gw, NGW, wave, lane);
            } else if (sub == 3 && (PHASE_MASK & 16)) {
                { pg8::Gemm g{(const bf16_t*)(ws + WS_AR + AR_YR), (const bf16_t*)(ws + WS_PRT), T, DM, DM}; pg8::StaticOrder S; S.init(T, DM, G, bid);
                  pg8::EpiProj1 E{(const bf16_t*)(ws + WS_AR + AR_SGR), (bf16_t*)(ws + WS_AR + AR_TMP)}; pg8::gemm_phase(lds, g, S, E); }
                { pg8::Gemm g{(const bf16_t*)(ws + WS_AR + AR_YA), (const bf16_t*)(ws + WS_PAT), T, DM, 512}; pg8::StaticOrder S; S.init(T, DM, G, bid);
                  pg8::EpiProj2 E{(const bf16_t*)(ws + WS_AR + AR_SGA), (const bf16_t*)(ws + WS_AR + AR_TMP), (bf16_t*)(ws + WS_AR + AR_MG)}; pg8::gemm_phase(lds, g, S, E); }
            } else if (sub == 4 && (PHASE_MASK & 32)) {
                pg8::Gemm g{(const bf16_t*)(ws + WS_AR + AR_MG), (const bf16_t*)(ws + WS_WOT), T, DM, DM}; pg8::StaticOrder S; S.init(T, DM, G, bid);
                pg8::EpiResid E{xout, XB, ssp, 0}; pg8::gemm_phase(lds, g, S, E);
            } else if (sub == 5 && (PHASE_MASK & 64)) {
                pg8::Gemm g{XB, (const bf16_t*)(ws + WS_WUT), T, NUP, DM}; pg8::StaticOrder S; S.init(T, NUP, G, bid);
                pg8::EpiUp E{ssp, (bf16_t*)(ws + WS_AR + AR_U)}; pg8::gemm_phase(lds, g, S, E);
            } else if (sub == 6 && (PHASE_MASK & 128)) {
                e2_convact(a, l, gtid, nthr);
                if (l + 1 < DEPTH && G != 256) convert_weights(a, l + 1, 8, lds, gw, NGW, wave, lane);
            } else if (sub == 7 && (PHASE_MASK & 256)) {
                pg8::Gemm g{(const bf16_t*)(ws + WS_AR + AR_ACT), (const bf16_t*)(ws + WS_WDT), T, DM, DFF}; pg8::StaticOrder S; S.init(T, DM, G, bid);
                pg8::EpiResid E{xout, XB, ssp, (l == DEPTH - 1) ? 1 : 0}; pg8::gemm_phase(lds, g, S, E);
            }
        }
        if (ph + 1 < a->ph_hi || PROBE_SEL >= 0) {
            if (USE_CG_SYNC || a->coop == 2) { cg::this_grid().sync(); }
            else xcd_barrier(bar);
        }
        if (PROBE_SEL >= 0 && blockIdx.x == 0 && threadIdx.x == 0) TS[ph + 1] = __builtin_amdgcn_s_memrealtime();
    }
    if (PROBE_SEL >= 0) {
        xcd_barrier(bar);
        unsigned long long tot = 0;
        if (PROBE_SEL < 8) { for (int l = 0; l < DEPTH; ++l) tot += TS[2 + 8 * l + PROBE_SEL] - TS[1 + 8 * l + PROBE_SEL]; }
        else if (PROBE_SEL == 8) tot = TS[1] - TS[0];
        else if (PROBE_SEL == 10) { for (int l = 0; l < DEPTH; ++l) tot += TS[64 + l] - TS[2 + 8 * l]; }
        else if (PROBE_SEL == 11) { for (int l = 0; l < DEPTH; ++l) tot += TS[72 + l] - TS[64 + l]; }
        else if (PROBE_SEL >= 14 && PROBE_SEL <= 16) tot = TS[96 + PROBE_SEL - 14];
        else if (PROBE_SEL == 12) { for (int l = 0; l < DEPTH; ++l) tot += (unsigned)TS[80 + l]; }
        else if (PROBE_SEL == 13) { for (int l = 0; l < DEPTH; ++l) tot += (unsigned)TS[88 + l]; }
        else tot = TS[NPHASE] - TS[0];
        const float v = (float)tot * 0.001f;
        if (blockIdx.x == 0 && threadIdx.x == 0) outF(a)[0] += v;
    }
}

extern "C" void kernel_launch(void* const* d_in, const int* in_sizes, int n_in, void* d_out, int out_size, void* d_ws, size_t ws_size, hipStream_t stream) {
    static int grid = 0;
    if (grid == 0) {
        if (n_in != 21 || out_size != T * DM || ws_size < WS_END) { fprintf(stderr, "kernel_launch: unexpected shapes (n_in %d out %d ws %zu, need %zu)\n", n_in, out_size, ws_size, (size_t)WS_END); grid = -1; return; }
        int dev = 0, cus = 0, per_cu = 0;
        hipGetDevice(&dev); hipDeviceGetAttribute(&cus, hipDeviceAttributeMultiprocessorCount, dev);
        if (hipFuncSetAttribute((const void*)mega, hipFuncAttributeMaxDynamicSharedMemorySize, LDS_BYTES) != hipSuccess) { fprintf(stderr, "kernel_launch: hipFuncSetAttribute failed\n"); grid = -1; return; }
        if (hipOccupancyMaxActiveBlocksPerMultiprocessor(&per_cu, (const void*)mega, 512, LDS_BYTES) != hipSuccess || per_cu < 1) { fprintf(stderr, "kernel_launch: occupancy query says %d\n", per_cu); per_cu = 1; }
        (void)hipGetLastError();
        grid = cus * 1;
        fprintf(stderr, "kernel_launch: grid %d (cus %d, per_cu %d)\n", grid, cus, per_cu);
    }
    if (grid < 0) return;
    Args a{};
    for (int i = 0; i < 21; ++i) a.in[i] = d_in[i];
    a.out = (float*)d_out; a.ws = (unsigned char*)d_ws; a.pad = 0;
    hipMemsetAsync((char*)d_ws + WS_CTL, 0, (PROBE_SEL >= 0) ? CTL_BYTES : (size_t)65536, stream);
#if MK_MULTI
    for (int p = 0; p < DBG_NPH; ++p) { a.ph_lo = p; a.ph_hi = p + 1; a.coop = 0; hipLaunchKernelGGL(mega, dim3(grid), dim3(512), LDS_BYTES, stream, a); }
#else
    a.ph_lo = 0; a.ph_hi = NPHASE; a.coop = 1;
    void* args[] = {&a};
    hipError_t e = hipLaunchCooperativeKernel((const void*)mega, dim3(grid), dim3(512), args, LDS_BYTES, stream);
    if (e != hipSuccess) fprintf(stderr, "kernel_launch: cooperative launch failed: %s (grid %d)\n", hipGetErrorString(e), grid);
#endif
}
```

```cpp
#include <hip/hip_runtime.h>
#include <hip/hip_cooperative_groups.h>
#include <cstdio>
namespace cg = cooperative_groups;

#ifndef MK_MULTI
#define MK_MULTI 0
#endif
#ifndef PHASE_MASK
#define PHASE_MASK 0x1ff
#endif
#ifndef PROBE_SEL
#define PROBE_SEL -1
#endif
#ifndef DBG_NPH
#define DBG_NPH 33
#endif
#ifndef USE_CG_SYNC
#define USE_CG_SYNC 0
#endif

#define DI __device__ __forceinline__
#define LAS __attribute__((address_space(3)))
typedef unsigned short bf16_t;
typedef short bf16x8 __attribute__((ext_vector_type(8)));
typedef float f32x2 __attribute__((ext_vector_type(2)));
typedef float f32x4 __attribute__((ext_vector_type(4)));
typedef float f32x16 __attribute__((ext_vector_type(16)));
typedef unsigned u32x2 __attribute__((ext_vector_type(2)));
typedef unsigned u32x4 __attribute__((ext_vector_type(4)));
typedef __bf16 bf16x2v __attribute__((ext_vector_type(2)));
typedef short s16x4 __attribute__((ext_vector_type(4)));

constexpr int T = 16384, SEQ = 2048, NBATCH = 8, DEPTH = 4;
constexpr int DM = 1024, NIN = 8704, AW = 1536, DFF = 3072, NUP = 6144;
constexpr float EPS = 1e-6f;

constexpr size_t MiB = 1u << 20;
constexpr size_t WS_CTL = 0, CTL_BYTES = 1 * MiB;
constexpr size_t WS_SSP = 1 * MiB;
constexpr size_t WS_AGGA = 2 * MiB, WS_AGGH = 3 * MiB;
constexpr size_t WS_LSE = 4 * MiB;
constexpr size_t WS_COS = 5 * MiB, WS_SIN = 9 * MiB;
constexpr size_t WS_W1T = 13 * MiB;
constexpr size_t WS_WUT = 30 * MiB;
constexpr size_t WS_WDT = 42 * MiB;
constexpr size_t WS_PRT = 48 * MiB;
constexpr size_t WS_PAT = 50 * MiB;
constexpr size_t WS_WOT = 51 * MiB;
constexpr size_t WS_WAT = 53 * MiB;
constexpr size_t WS_WXT = 53 * MiB + 262144;
constexpr size_t WS_XB = 54 * MiB;
constexpr size_t WS_AR = 86 * MiB;
constexpr size_t AR_XR = 0, AR_YR = 0;
constexpr size_t AR_GG = 32 * MiB, AR_MG = 32 * MiB;
constexpr size_t AR_SGR = 64 * MiB, AR_SGA = 96 * MiB;
constexpr size_t AR_Q = 128 * MiB, AR_K = 176 * MiB, AR_V = 224 * MiB;
constexpr size_t AR_YA = 128 * MiB, AR_TMP = 144 * MiB;
constexpr size_t AR_HL = 272 * MiB, AR_OG = 336 * MiB;
constexpr size_t AR_U = 0, AR_ACT = 192 * MiB;
constexpr size_t WS_END = WS_AR + 384 * MiB;

constexpr int RING_BYTES = 131072;
constexpr int TAB_OFF = RING_BYTES;
constexpr int MISC_OFF = RING_BYTES + 8192;
constexpr int LDS_BYTES = 147456;

#define LDS_WAIT() asm volatile("s_waitcnt lgkmcnt(0)" ::: "memory")
DI unsigned f2bf(float f) { unsigned u = __builtin_bit_cast(unsigned, f); return (u + 0x7fffu + ((u >> 16) & 1u)) >> 16; }
DI unsigned pk2(float lo, float hi) { f32x2 v = {lo, hi}; return __builtin_bit_cast(unsigned, __builtin_convertvector(v, bf16x2v)); }
DI float bflo(unsigned w) { return __builtin_bit_cast(float, w << 16); }
DI float bfhi(unsigned w) { return __builtin_bit_cast(float, w & 0xffff0000u); }
DI float frcp(float x) { return __builtin_amdgcn_rcpf(x); }
DI float fexp(float x) { return __builtin_amdgcn_exp2f(x * 1.4426950408889634f); }
DI float sigmoidf_(float x) { return frcp(1.0f + fexp(-x)); }
DI float gelu_tanh(float x) { const float y = 1.5957691216057308f * (x + 0.044715f * x * x * x); return x * frcp(1.0f + fexp(-y)); }
DI float one_minus_exp(float y) { const float ser = -y * (1.0f + y * (0.5f + y * (0.16666667f + y * (0.041666668f + y * (0.0083333333f + y * 0.0013888889f))))); return (y > -0.3f) ? ser : (1.0f - fexp(y)); }
DI unsigned pkh2(float lo, float hi) { const _Float16 a = (_Float16)lo, b = (_Float16)hi; return (unsigned)__builtin_bit_cast(unsigned short, a) | ((unsigned)__builtin_bit_cast(unsigned short, b) << 16); }
DI float hlo(unsigned w) { return (float)__builtin_bit_cast(_Float16, (unsigned short)(w & 0xffffu)); }
DI float hhi(unsigned w) { return (float)__builtin_bit_cast(_Float16, (unsigned short)(w >> 16)); }

namespace pg8 {
constexpr int BM = 256, BK = 64, HALF = 128, HTB = HALF * BK * 2, NXCD = 8, WGM = 8;
DI int lds_byte(int r, int c) { const int st = (r >> 4) * 2 + (c >> 5), rr = r & 15, cc = c & 31, ob = rr * 64 + cc * 2; return st * 1024 + (ob ^ (((ob >> 9) & 1) << 5)); }
DI void stage_rc(int b, int& R, int& C) { const int st = b / 1024, sb = b % 1024, swz = sb ^ (((sb >> 9) & 1) << 5); R = (st >> 1) * 16 + swz / 64; C = (st & 1) * 32 + (swz % 64) / 2; }
DI int perm32(int rho) { const int n = rho >> 4, i = rho & 15; return 8 * (i >> 2) + 4 * n + (i & 3); }
struct Unit { int pm, pn; };
struct Gemm { const bf16_t* A; const bf16_t* Bt; int M, N, K; };
struct StaticOrder {
    int nM, nN, nwg, G, c;
    DI void init(int M, int N, int G_, int c_) { nM = M / BM; nN = N / BM; nwg = nM * nN; G = G_; c = c_; }
    DI bool next(int i, Unit& u) const {
        const long L = (long)i * G + c; if (L >= nwg) return false;
        int wgid = (int)L; { const int q = nwg / NXCD, r = nwg % NXCD, xcd = wgid % NXCD, off = wgid / NXCD; wgid = (xcd < r ? xcd * (q + 1) : r * (q + 1) + (xcd - r) * q) + off; }
        const int nig = WGM * nN, gid = wgid / nig, fm = gid * WGM, gsz = (nM - fm) < WGM ? (nM - fm) : WGM;
        u.pm = fm + ((wgid % nig) % gsz); u.pn = (wgid % nig) / gsz; return true;
    }
};
DI unsigned cvt_pk_bf16(float lo, float hi) { return pk2(lo, hi); }

template <class Epi, bool ALIGN_EPI = true, bool SP2 = true>
DI void gemm_phase(LAS unsigned char* lds, const Gemm g, const StaticOrder& S, const Epi& E) {
    int tid = threadIdx.x; asm volatile("" : "+v"(tid));
    const int wid = __builtin_amdgcn_readfirstlane(tid >> 6), lane = tid & 63, wr = wid >> 2, wc = wid & 3, fr = lane & 15, fq = lane >> 4;
    const int K = g.K, nt = K / BK;
    unsigned voffA[2], voffB[2];
#pragma unroll
    for (int i = 0; i < 2; ++i) { int R, C; stage_rc(tid * 16 + i * 8192, R, C); const int Rb = (R & ~31) + perm32(R & 31);
        voffA[i] = (unsigned)(R * K + C) * 2u; voffB[i] = (unsigned)(Rb * K + C) * 2u; }
    const size_t kstep = (size_t)(BK * 2);
    const size_t hstep = (size_t)HALF * K * 2;
    const size_t tstep = 2 * hstep;
    const unsigned ldsw = (unsigned)wid * 1024u;
    const int aoff = lds_byte(wr * 64 + fr, fq * 8), boff = lds_byte(wc * 32 + fr, fq * 8);
#define PG8_SA(b, h) (((b) * 2 + (h)) * HTB)
#define PG8_SB(b, h) ((4 + (b) * 2 + (h)) * HTB)
#define PG8_STAGE(bufoff, gbase, voff) do { _Pragma("unroll") for (int _i = 0; _i < 2; ++_i) \
        __builtin_amdgcn_global_load_lds((const unsigned*)((const char*)(gbase) + (voff)[_i]), (LAS unsigned*)(lds + (bufoff) + ldsw + _i * 8192), 16, 0, 0); } while (0)
#define PG8_LDA(dst, b, h) do { _Pragma("unroll") for (int m = 0; m < 4; ++m) _Pragma("unroll") for (int k = 0; k < 2; ++k) dst[m][k] = *(const LAS bf16x8*)(lds + PG8_SA(b, h) + aoff + m * 2048 + k * 1024); } while (0)
#define PG8_LDB(dst, b, h) do { _Pragma("unroll") for (int n = 0; n < 2; ++n) _Pragma("unroll") for (int k = 0; k < 2; ++k) dst[n][k] = *(const LAS bf16x8*)(lds + PG8_SB(b, h) + boff + n * 2048 + k * 1024); } while (0)
#define PG8_MMA(ai, bj, At, Bt) do { __builtin_amdgcn_s_setprio(1); _Pragma("unroll") for (int m = 0; m < 4; ++m) _Pragma("unroll") for (int n = 0; n < 2; ++n) _Pragma("unroll") for (int k = 0; k < 2; ++k) \
        acc[ai][bj][m][n] = __builtin_amdgcn_mfma_f32_16x16x32_bf16(Bt[n][k], At[m][k], acc[ai][bj][m][n], 0, 0, 0); __builtin_amdgcn_s_setprio(0); } while (0)
#define PG8_WAIT_V(n) asm volatile("s_waitcnt vmcnt(" #n ")" ::: "memory")
#define PG8_WAIT_L(n) asm volatile("s_waitcnt lgkmcnt(" #n ")" ::: "memory")
#define PG8_BAR __builtin_amdgcn_s_barrier()
#define PG8_SCHED __builtin_amdgcn_sched_barrier(0)
    Unit cur, nxt; int ui = 0;
    if (!S.next(0, cur)) return;
    f32x4 acc[2][2][4][2];
#pragma unroll
    for (int a = 0; a < 2; ++a)
#pragma unroll
        for (int b = 0; b < 2; ++b)
#pragma unroll
            for (int m = 0; m < 4; ++m)
#pragma unroll
                for (int n = 0; n < 2; ++n) acc[a][b][m][n] = (f32x4){0.f, 0.f, 0.f, 0.f};
    bf16x8 At[4][2], B0[2][2], B1[2][2];
    const char* cA = (const char*)g.A + (size_t)cur.pm * tstep; const char* cB = (const char*)g.Bt + (size_t)cur.pn * tstep;
    if constexpr (SP2) {
        PG8_STAGE(PG8_SB(0, 0), cB, voffB); PG8_STAGE(PG8_SB(0, 1), cB + hstep, voffB); PG8_STAGE(PG8_SA(0, 0), cA, voffA); PG8_STAGE(PG8_SA(0, 1), cA + hstep, voffA);
        if (wr == 1) PG8_BAR;
        PG8_WAIT_V(2); PG8_BAR;
        PG8_STAGE(PG8_SB(1, 0), cB + kstep, voffB); PG8_STAGE(PG8_SA(1, 0), cA + kstep, voffA); PG8_STAGE(PG8_SB(1, 1), cB + hstep + kstep, voffB);
        PG8_WAIT_V(6); PG8_BAR;
    } else {
        PG8_STAGE(PG8_SB(0, 0), cB, voffB); PG8_STAGE(PG8_SA(0, 0), cA, voffA); PG8_STAGE(PG8_SB(0, 1), cB + hstep, voffB); PG8_STAGE(PG8_SA(0, 1), cA + hstep, voffA);
        if (wr == 1) PG8_BAR;
        PG8_WAIT_V(4); PG8_BAR;
        PG8_STAGE(PG8_SB(1, 0), cB + kstep, voffB); PG8_STAGE(PG8_SA(1, 0), cA + kstep, voffA); PG8_STAGE(PG8_SB(1, 1), cB + hstep + kstep, voffB);
        PG8_WAIT_V(6); PG8_BAR;
    }
    for (;;) {
        const bool has_next = S.next(ui + 1, nxt);
        const char* nA = has_next ? (const char*)g.A + (size_t)nxt.pm * tstep : cA; const char* nB = has_next ? (const char*)g.Bt + (size_t)nxt.pn * tstep : cB;
        for (int t = 0; t < nt; t += 2) {
            const bool last = (t == nt - 2);
            const char* a1 = cA + (size_t)(t + 1) * kstep;
            const char* a2 = last ? nA : cA + (size_t)(t + 2) * kstep; const char* b2 = last ? nB : cB + (size_t)(t + 2) * kstep;
            const char* a3 = a2 + kstep; const char* b3 = b2 + kstep;
            if constexpr (SP2) {
            PG8_LDB(B0, 0, 0); PG8_LDB(B1, 0, 1); PG8_SCHED; PG8_LDA(At, 0, 0); PG8_STAGE(PG8_SA(1, 1), a1 + hstep, voffA);
            PG8_WAIT_V(8); PG8_WAIT_L(0); PG8_BAR; PG8_MMA(0, 0, At, B0); PG8_MMA(0, 1, At, B1); PG8_BAR; PG8_SCHED;
            PG8_LDA(At, 0, 1); PG8_STAGE(PG8_SB(0, 0), b2, voffB); PG8_STAGE(PG8_SB(0, 1), b2 + hstep, voffB); PG8_STAGE(PG8_SA(0, 0), a2, voffA);
            PG8_WAIT_V(8); PG8_WAIT_L(0); PG8_BAR; PG8_MMA(1, 0, At, B0); PG8_MMA(1, 1, At, B1); PG8_BAR; PG8_SCHED;
            PG8_LDB(B0, 1, 0); PG8_LDB(B1, 1, 1); PG8_SCHED; PG8_LDA(At, 1, 0); PG8_STAGE(PG8_SA(0, 1), a2 + hstep, voffA);
            PG8_WAIT_V(8); PG8_WAIT_L(0); PG8_BAR; PG8_MMA(0, 0, At, B0); PG8_MMA(0, 1, At, B1); PG8_BAR; PG8_SCHED;
            PG8_LDA(At, 1, 1); PG8_STAGE(PG8_SB(1, 0), b3, voffB); PG8_STAGE(PG8_SB(1, 1), b3 + hstep, voffB); PG8_STAGE(PG8_SA(1, 0), a3, voffA);
            PG8_WAIT_V(8); PG8_WAIT_L(0); PG8_BAR; PG8_MMA(1, 0, At, B0); PG8_MMA(1, 1, At, B1); PG8_BAR; PG8_SCHED;
            } else {
            PG8_LDB(B0, 0, 0); PG8_SCHED; PG8_LDA(At, 0, 0); PG8_STAGE(PG8_SA(1, 1), a1 + hstep, voffA);
            PG8_WAIT_L(8); PG8_BAR; PG8_WAIT_L(0); PG8_MMA(0, 0, At, B0); PG8_BAR; PG8_SCHED;
            PG8_LDB(B1, 0, 1); PG8_STAGE(PG8_SB(0, 0), b2, voffB);
            PG8_BAR; PG8_WAIT_L(0); PG8_MMA(0, 1, At, B1); PG8_BAR;
            PG8_LDA(At, 0, 1); PG8_STAGE(PG8_SA(0, 0), a2, voffA);
            PG8_BAR; PG8_WAIT_L(0); PG8_MMA(1, 0, At, B0); PG8_BAR; PG8_SCHED;
            PG8_STAGE(PG8_SB(0, 1), b2 + hstep, voffB);
            PG8_WAIT_V(6); PG8_BAR; PG8_MMA(1, 1, At, B1); PG8_BAR;
            PG8_LDB(B0, 1, 0); PG8_SCHED; PG8_LDA(At, 1, 0); PG8_STAGE(PG8_SA(0, 1), a2 + hstep, voffA);
            PG8_WAIT_L(8); PG8_BAR; PG8_WAIT_L(0); PG8_MMA(0, 0, At, B0); PG8_BAR; PG8_SCHED;
            PG8_LDB(B1, 1, 1); PG8_STAGE(PG8_SB(1, 0), b3, voffB);
            PG8_BAR; PG8_WAIT_L(0); PG8_MMA(0, 1, At, B1); PG8_BAR;
            PG8_LDA(At, 1, 1); PG8_STAGE(PG8_SA(1, 0), a3, voffA);
            PG8_BAR; PG8_WAIT_L(0); PG8_MMA(1, 0, At, B0); PG8_BAR; PG8_SCHED;
            PG8_STAGE(PG8_SB(1, 1), b3 + hstep, voffB);
            PG8_WAIT_V(6); PG8_BAR; PG8_MMA(1, 1, At, B1); PG8_BAR;
            }
        }
        if constexpr (ALIGN_EPI) { if (wr == 0) PG8_BAR; }
        E(acc, cur, wr, wc, fr, fq);
        if (!has_next) break;
#pragma unroll
        for (int a = 0; a < 2; ++a)
#pragma unroll
            for (int b = 0; b < 2; ++b)
#pragma unroll
                for (int m = 0; m < 4; ++m)
#pragma unroll
                    for (int n = 0; n < 2; ++n) acc[a][b][m][n] = (f32x4){0.f, 0.f, 0.f, 0.f};
        cur = nxt; cA = nA; cB = nB; ++ui;
        if constexpr (ALIGN_EPI) { if (wr == 1) PG8_BAR; }
    }
    PG8_WAIT_V(0);
    if constexpr (!ALIGN_EPI) { if (wr == 0) PG8_BAR; }
    PG8_BAR;
#undef PG8_SA
#undef PG8_SB
#undef PG8_STAGE
#undef PG8_LDA
#undef PG8_LDB
#undef PG8_MMA
#undef PG8_WAIT_V
#undef PG8_WAIT_L
#undef PG8_BAR
#undef PG8_SCHED
}

typedef f32x4 Acc[2][2][4][2];

DI void row_scales(const float* ssp, int row0, int fq, float (&rs)[2][4]) {
#pragma unroll
    for (int ai = 0; ai < 2; ++ai)
#pragma unroll
        for (int m = 0; m < 4; ++m) {
            const f32x4 p = *(const f32x4*)(ssp + (size_t)(row0 + ai * HALF + m * 16) * 16 + 4 * fq);
            float s = (p.x + p.y) + (p.z + p.w); s += __shfl_xor(s, 16); s += __shfl_xor(s, 32);
            rs[ai][m] = rsqrtf(s * (1.0f / 1024.0f) + EPS);
        }
}

DI float row_scale1(const float* ssp, int row, int fq) {
    const f32x4 p = *(const f32x4*)(ssp + (size_t)row * 16 + 4 * fq);
    float s = (p.x + p.y) + (p.z + p.w); s += __shfl_xor(s, 16); s += __shfl_xor(s, 32);
    return rsqrtf(s * (1.0f / 1024.0f) + EPS);
}
template <int ACT> DI void store_plain(Acc& acc, const float* ssp, bf16_t* O, int ldc, int row0, int col0, int fq) {
    float rs[2][4]; row_scales(ssp, row0, fq, rs);
#pragma unroll
    for (int ai = 0; ai < 2; ++ai)
#pragma unroll
        for (int m = 0; m < 4; ++m) { int r0v = row0; asm volatile("" : "+v"(r0v)); const int row = r0v + ai * HALF + m * 16; bf16_t* rowp = O + (size_t)row * ldc + col0; const float s = rs[ai][m];
#pragma unroll
            for (int bj = 0; bj < 2; ++bj) { f32x4 v0 = acc[ai][bj][m][0] * s, v1 = acc[ai][bj][m][1] * s;
                if (ACT == 1) {
#pragma unroll
                    for (int j = 0; j < 4; ++j) { v0[j] = gelu_tanh(v0[j]); v1[j] = gelu_tanh(v1[j]); } }
                if (ACT == 2) {
#pragma unroll
                    for (int j = 0; j < 4; ++j) { v0[j] = sigmoidf_(v0[j]); v1[j] = sigmoidf_(v1[j]); } }
                u32x4 w; w.x = cvt_pk_bf16(v0[0], v0[1]); w.y = cvt_pk_bf16(v0[2], v0[3]); w.z = cvt_pk_bf16(v1[0], v1[1]); w.w = cvt_pk_bf16(v1[2], v1[3]);
                *(u32x4*)(rowp + bj * HALF) = w; } }
}
struct EpiIn {
    const float* ssp; bf16_t *XR, *GG, *SGR, *SGA, *Q, *Kc, *V; const float *qg, *kg, *cosT, *sinT; LAS float* tab;
    DI void operator()(Acc& acc, const Unit& u, int wr, int wc, int fr, int fq) const {
        const int row0 = u.pm * BM + wr * 64 + fr, pn = u.pn;
        if (pn < 16 || pn >= 28) {
            const int cw = wc * 32 + 8 * fq;
            if (pn < 4) store_plain<0>(acc, ssp, XR, 1024, row0, pn * 256 + cw, fq);
            else if (pn < 8) store_plain<1>(acc, ssp, GG, 1024, row0, (pn - 4) * 256 + cw, fq);
            else if (pn < 12) store_plain<2>(acc, ssp, SGR, 1024, row0, (pn - 8) * 256 + cw, fq);
            else if (pn < 16) store_plain<2>(acc, ssp, SGA, 1024, row0, (pn - 12) * 256 + cw, fq);
            else store_plain<0>(acc, ssp, V, 1536, row0, (pn - 28) * 256 + cw, fq);
        } else {
            const bool isq = pn < 22; const int head0 = 2 * (pn - (isq ? 16 : 22)); bf16_t* O = isq ? Q : Kc; const float* gw = isq ? qg : kg; const float osc = isq ? 0.08838834764831845f : 1.0f;
            const int d0 = 16 * wc + 4 * fq;
            float rs[2][4]; row_scales(ssp, row0, fq, rs);
#pragma unroll
            for (int ai = 0; ai < 2; ++ai)
#pragma unroll
                for (int m = 0; m < 4; ++m) { int r0v = row0; asm volatile("" : "+v"(r0v)); const float s = rs[ai][m]; const int rl = (r0v & 255) + ai * HALF + m * 16;
#pragma unroll
                    for (int bj = 0; bj < 2; ++bj) { const f32x4 a = acc[ai][bj][m][0], b = acc[ai][bj][m][1];
                        float q = (a[0] * a[0] + a[1] * a[1]) + (a[2] * a[2] + a[3] * a[3]) + (b[0] * b[0] + b[1] * b[1]) + (b[2] * b[2] + b[3] * b[3]);
                        q *= s * s; q += __shfl_xor(q, 16); q += __shfl_xor(q, 32);
                        if (fq == 0) tab[(rl * 2 + bj) * 4 + wc] = q; } }
            asm volatile("s_waitcnt lgkmcnt(0)" ::: "memory"); __builtin_amdgcn_s_barrier(); asm volatile("" ::: "memory");
            const f32x4 g1a = *(const f32x4*)(gw + head0 * 128 + d0), g2a = *(const f32x4*)(gw + head0 * 128 + 64 + d0);
            const f32x4 g1b = *(const f32x4*)(gw + head0 * 128 + 128 + d0), g2b = *(const f32x4*)(gw + head0 * 128 + 192 + d0);
#pragma unroll
            for (int ai = 0; ai < 2; ++ai)
#pragma unroll
                for (int m = 0; m < 4; ++m) { int r0v = row0; asm volatile("" : "+v"(r0v)); const int rl = (r0v & 255) + ai * HALF + m * 16; const size_t row = (size_t)(r0v + ai * HALF + m * 16);
                    const f32x4 cs = *(const f32x4*)(cosT + row * 64 + d0), sn = *(const f32x4*)(sinT + row * 64 + d0); const float s = rs[ai][m] * osc;
#pragma unroll
                    for (int bj = 0; bj < 2; ++bj) { const f32x4 pp = *(const LAS f32x4*)(tab + (rl * 2 + bj) * 4);
                        const float inv = rsqrtf(((pp.x + pp.y) + (pp.z + pp.w)) * (1.0f / 128.0f) + EPS) * s;
                        const f32x4 x1 = acc[ai][bj][m][0] * inv * (bj ? g1b : g1a), x2 = acc[ai][bj][m][1] * inv * (bj ? g2b : g2a);
                        const f32x4 o1 = x1 * cs - x2 * sn, o2 = x2 * cs + x1 * sn;
                        u32x2 w1, w2; w1.x = cvt_pk_bf16(o1[0], o1[1]); w1.y = cvt_pk_bf16(o1[2], o1[3]); w2.x = cvt_pk_bf16(o2[0], o2[1]); w2.y = cvt_pk_bf16(o2[2], o2[3]);
                        bf16_t* p = O + row * AW + (head0 + bj) * 128 + d0; *(u32x2*)p = w1; *(u32x2*)(p + 64) = w2; }
                    if (m & 1) asm volatile("" ::: "memory"); }
        }
    }
};
struct EpiProj1 {
    const bf16_t* SG; bf16_t* TMP;
    DI void operator()(Acc& acc, const Unit& u, int wr, int wc, int fr, int fq) const {
        const int row0 = u.pm * BM + wr * 64 + fr, col0 = u.pn * BM + wc * 32 + 8 * fq;
#pragma unroll
        for (int ai = 0; ai < 2; ++ai)
#pragma unroll
            for (int m = 0; m < 4; ++m) { int r0v = row0; asm volatile("" : "+v"(r0v)); const size_t off = (size_t)(r0v + ai * HALF + m * 16) * DM + col0;
#pragma unroll
                for (int bj = 0; bj < 2; ++bj) { const u32x4 sg = *(const u32x4*)(SG + off + bj * HALF);
                    f32x4 v0 = acc[ai][bj][m][0], v1 = acc[ai][bj][m][1];
                    v0[0] *= bflo(sg.x); v0[1] *= bfhi(sg.x); v0[2] *= bflo(sg.y); v0[3] *= bfhi(sg.y); v1[0] *= bflo(sg.z); v1[1] *= bfhi(sg.z); v1[2] *= bflo(sg.w); v1[3] *= bfhi(sg.w);
                    u32x4 w; w.x = cvt_pk_bf16(v0[0], v0[1]); w.y = cvt_pk_bf16(v0[2], v0[3]); w.z = cvt_pk_bf16(v1[0], v1[1]); w.w = cvt_pk_bf16(v1[2], v1[3]);
                    *(u32x4*)(TMP + off + bj * HALF) = w; }
                if (m & 1) asm volatile("" ::: "memory"); }
    }
};
struct EpiProj2 {
    const bf16_t* SG; const bf16_t* TMP; bf16_t* MG;
    DI void operator()(Acc& acc, const Unit& u, int wr, int wc, int fr, int fq) const {
        const int row0 = u.pm * BM + wr * 64 + fr, col0 = u.pn * BM + wc * 32 + 8 * fq;
#pragma unroll
        for (int ai = 0; ai < 2; ++ai)
#pragma unroll
            for (int m = 0; m < 4; ++m) { int r0v = row0; asm volatile("" : "+v"(r0v)); const size_t off = (size_t)(r0v + ai * HALF + m * 16) * DM + col0;
#pragma unroll
                for (int bj = 0; bj < 2; ++bj) { const u32x4 sg = *(const u32x4*)(SG + off + bj * HALF); const u32x4 tm = *(const u32x4*)(TMP + off + bj * HALF);
                    f32x4 v0 = acc[ai][bj][m][0], v1 = acc[ai][bj][m][1];
                    v0[0] = bflo(tm.x) + v0[0] * bflo(sg.x); v0[1] = bfhi(tm.x) + v0[1] * bfhi(sg.x); v0[2] = bflo(tm.y) + v0[2] * bflo(sg.y); v0[3] = bfhi(tm.y) + v0[3] * bfhi(sg.y);
                    v1[0] = bflo(tm.z) + v1[0] * bflo(sg.z); v1[1] = bfhi(tm.z) + v1[1] * bfhi(sg.z); v1[2] = bflo(tm.w) + v1[2] * bflo(sg.w); v1[3] = bfhi(tm.w) + v1[3] * bfhi(sg.w);
                    u32x4 w; w.x = cvt_pk_bf16(v0[0], v0[1]); w.y = cvt_pk_bf16(v0[2], v0[3]); w.z = cvt_pk_bf16(v1[0], v1[1]); w.w = cvt_pk_bf16(v1[2], v1[3]);
                    *(u32x4*)(MG + off + bj * HALF) = w; }
                if (m & 1) asm volatile("" ::: "memory"); }
    }
};
struct EpiResid {
    float* xout; bf16_t* XB; float* ssp; int final_;
    DI void operator()(Acc& acc, const Unit& u, int wr, int wc, int fr, int fq) const {
        const int row0 = u.pm * BM + wr * 64 + fr, col0 = u.pn * BM + wc * 32 + 8 * fq;
#pragma unroll
        for (int ai = 0; ai < 2; ++ai)
#pragma unroll
            for (int m = 0; m < 4; ++m) { int r0v = row0; asm volatile("" : "+v"(r0v)); const int row = r0v + ai * HALF + m * 16; const size_t off = (size_t)row * DM + col0; float q = 0.f;
#pragma unroll
                for (int bj = 0; bj < 2; ++bj) {
                    const u32x4 xo = *(const u32x4*)(XB + off + bj * HALF);
                    f32x4 o0 = acc[ai][bj][m][0], o1 = acc[ai][bj][m][1];
                    o0[0] += bflo(xo.x); o0[1] += bfhi(xo.x); o0[2] += bflo(xo.y); o0[3] += bfhi(xo.y); o1[0] += bflo(xo.z); o1[1] += bfhi(xo.z); o1[2] += bflo(xo.w); o1[3] += bfhi(xo.w);
                    q += (o0[0] * o0[0] + o0[1] * o0[1]) + (o0[2] * o0[2] + o0[3] * o0[3]) + (o1[0] * o1[0] + o1[1] * o1[1]) + (o1[2] * o1[2] + o1[3] * o1[3]);
                    if (final_) { *(f32x4*)(xout + off + bj * HALF) = o0; *(f32x4*)(xout + off + bj * HALF + 4) = o1; }
                    else { u32x4 w; w.x = cvt_pk_bf16(o0[0], o0[1]); w.y = cvt_pk_bf16(o0[2], o0[3]); w.z = cvt_pk_bf16(o1[0], o1[1]); w.w = cvt_pk_bf16(o1[2], o1[3]);
                        *(u32x4*)(XB + off + bj * HALF) = w; } }
                q += __shfl_xor(q, 16); q += __shfl_xor(q, 32);
                if (fq == 0) ssp[(size_t)row * 16 + u.pn * 4 + wc] = q;
                if (m & 1) asm volatile("" ::: "memory"); }
    }
};
struct EpiUp {
    const float* ssp; bf16_t* U;
    DI void operator()(Acc& acc, const Unit& u, int wr, int wc, int fr, int fq) const {
        const int row0 = u.pm * BM + wr * 64 + fr, col0 = u.pn * BM + wc * 32 + 8 * fq;
        float rs[2][4]; row_scales(ssp, row0, fq, rs);
#pragma unroll
        for (int ai = 0; ai < 2; ++ai)
#pragma unroll
            for (int m = 0; m < 4; ++m) { int r0v = row0; asm volatile("" : "+v"(r0v)); const int row = r0v + ai * HALF + m * 16; bf16_t* rowp = U + (size_t)row * NUP + col0; const float s = rs[ai][m];
#pragma unroll
                for (int bj = 0; bj < 2; ++bj) { const f32x4 v0 = acc[ai][bj][m][0] * s, v1 = acc[ai][bj][m][1] * s;
                    u32x4 w; w.x = cvt_pk_bf16(v0[0], v0[1]); w.y = cvt_pk_bf16(v0[2], v0[3]); w.z = cvt_pk_bf16(v1[0], v1[1]); w.w = cvt_pk_bf16(v1[2], v1[3]);
                    *(u32x4*)(rowp + bj * HALF) = w; } }
    }
};
}

#define XB_TMO      128
#define XB_XCNT(j)  (256  + 64 * (j))
#define XB_XSUB(j)  (1280 + 64 * (j))
#define XB_XGEN(j)  (2304 + 64 * (j))
#define XB_TOP      3328
#define XB_TOPGEN   3392
#define XB_SPIN_CAP (1u << 22)
DI unsigned xb_ld(unsigned* p)              { return __hip_atomic_load(p, __ATOMIC_RELAXED, __HIP_MEMORY_SCOPE_AGENT); }
DI unsigned xb_add(unsigned* p, unsigned v) { return __hip_atomic_fetch_add(p, v, __ATOMIC_RELAXED, __HIP_MEMORY_SCOPE_AGENT); }
DI unsigned xb_xcc_id() { return (unsigned)__builtin_amdgcn_s_getreg((3 << 11) | 20) & 0xFu; }
#define XB_SPIN(cond, bar) do { unsigned _sp = 0; while (cond) { __builtin_amdgcn_s_sleep(1); \
    if ((++_sp & 255u) == 0u) { if (xb_ld(&(bar)[XB_TMO])) break; if (_sp > XB_SPIN_CAP) { atomicAdd(&(bar)[XB_TMO], 1u); break; } } } } while (0)
struct XcdBarrier { unsigned* bar; unsigned x; volatile LAS unsigned* st; };
DI XcdBarrier xcd_barrier_post(unsigned* bar, volatile LAS unsigned* st) {
    XcdBarrier b; b.bar = bar; b.x = xb_xcc_id(); b.st = st;
    if (threadIdx.x == 0) (void)xb_add(&bar[XB_XCNT(b.x)], 1u);
    return b;
}
DI void xcd_barrier_complete(unsigned* bar, unsigned x, unsigned& nloc, unsigned& nx) {
    const unsigned G = gridDim.x * gridDim.y * gridDim.z;
    unsigned sum, cnt, mine, sp = 0u;
    for (;;) {
        sum = 0u; cnt = 0u; mine = 0u;
#pragma unroll
        for (unsigned j = 0; j < 16; ++j) { const unsigned c = xb_ld(&bar[XB_XCNT(j)]); sum += c; cnt += (c > 0u) ? 1u : 0u; mine = (j == x) ? c : mine; }
        if (sum == G) break;
        __builtin_amdgcn_s_sleep(1);
        if ((++sp & 255u) == 0u) { if (xb_ld(&bar[XB_TMO])) break; if (sp > XB_SPIN_CAP) { atomicAdd(&bar[XB_TMO], 1u); break; } }
    }
    nloc = mine > 0u ? mine : 1u; nx = cnt > 0u ? cnt : 1u;
}
DI void xcd_barrier(const XcdBarrier& b) {
    asm volatile("s_waitcnt vmcnt(0)" ::: "memory");
    __syncthreads();
    if (threadIdx.x == 0) {
        unsigned* bar = b.bar;
        __builtin_amdgcn_s_waitcnt(0);
        unsigned nloc = b.st[0], nx = b.st[1];
        if (nloc == 0u) { xcd_barrier_complete(bar, b.x, nloc, nx); b.st[0] = nloc; b.st[1] = nx; }
        const unsigned old = xb_add(&bar[XB_XSUB(b.x)], 1u);
        const unsigned gen = old / nloc;
        if (old + 1u == (gen + 1u) * nloc) {
            __builtin_amdgcn_fence(__ATOMIC_RELEASE, "agent");
            asm volatile("s_waitcnt vmcnt(0)" ::: "memory");
            const unsigned og = xb_add(&bar[XB_TOP], 1u);
            const unsigned tg = og / nx;
            if (og + 1u == (tg + 1u) * nx) xb_add(&bar[XB_TOPGEN], 1u);
            else XB_SPIN(xb_ld(&bar[XB_TOPGEN]) == tg, bar);
            __builtin_amdgcn_fence(__ATOMIC_ACQUIRE, "agent");
            xb_add(&bar[XB_XGEN(b.x)], 1u);
            asm volatile("s_waitcnt vmcnt(0)" ::: "memory");
        } else {
            XB_SPIN(xb_ld(&bar[XB_XGEN(b.x)]) == gen, bar);
            __builtin_amdgcn_fence(__ATOMIC_ACQUIRE, "agent");
            asm volatile("s_waitcnt vmcnt(0)" ::: "memory");
        }
    }
    __syncthreads();
}

struct Args { const void* in[21]; float* out; unsigned char* ws; int ph_lo, ph_hi, coop, pad; };
typedef const Args __attribute__((address_space(4)))* CArgsP;
#define GAS1 __attribute__((address_space(1)))
DI const float* inF(CArgsP a, int k) { return (const float*)(GAS1 const float*)a->in[k]; }
DI const int* inI(CArgsP a, int k) { return (const int*)(GAS1 const int*)a->in[k]; }
DI float* outF(CArgsP a) { return (float*)(GAS1 float*)a->out; }
DI unsigned char* wsG(CArgsP a) { return (unsigned char*)(GAS1 unsigned char*)a->ws; }

DI int qkperm(int d) { return 32 * ((d >> 4) & 3) + 8 * ((d >> 2) & 3) + 4 * (d >> 6) + (d & 3); }
DI int map_in(int n) {
    if (n < 2048) return n;
    if (n < 3584) { const int e = n - 2048; return 4096 + (e & ~127) + qkperm(e & 127); }
    if (n < 5120) { const int e = n - 3584; return 5632 + (e & ~127) + qkperm(e & 127); }
    if (n < 6656) return 7168 + (n - 5120);
    return 2048 + (n - 6656);
}
DI void transpose_item(const float* W, int K, int N, bf16_t* WT, const float* gk, int mapkind, LAS float* scr, int item, int lane) {
    const int nblk = N / 32, kb = item / nblk, nb = item % nblk, k0 = 64 * kb, n0 = 32 * nb;
    float wv[32];
    const float* wp = W + (size_t)(k0 + (lane >> 5)) * N + n0 + (lane & 31);
#pragma unroll
    for (int i = 0; i < 32; ++i) wv[i] = __builtin_nontemporal_load(wp + (size_t)(2 * i) * N);
    if (gk) {
        const float* gp = gk + k0 + (lane >> 5);
#pragma unroll
        for (int i = 0; i < 32; ++i) wv[i] *= gp[2 * i]; }
#pragma unroll
    for (int i = 0; i < 32; ++i) scr[(2 * i + (lane >> 5)) * 33 + (lane & 31)] = wv[i];
    LDS_WAIT(); asm volatile("" ::: "memory");
    const int c = lane & 7;
#pragma unroll
    for (int j = 0; j < 4; ++j) { const int n = (lane >> 3) + 8 * j; const LAS float* s = scr + (8 * c) * 33 + n;
        u32x4 o; o.x = pk2(s[0 * 33], s[1 * 33]); o.y = pk2(s[2 * 33], s[3 * 33]); o.z = pk2(s[4 * 33], s[5 * 33]); o.w = pk2(s[6 * 33], s[7 * 33]);
        const int dst = mapkind ? map_in(n0 + n) : (n0 + n);
        *(u32x4*)(WT + (size_t)dst * K + k0 + 8 * c) = o; }
    LDS_WAIT(); asm volatile("" ::: "memory");
}
DI void convert_weights(CArgsP a, int l, int mask, LAS unsigned char* lds, int gw, int NGW, int wave, int lane) {
    LAS float* scr = (LAS float*)(lds + wave * 8448);
    unsigned char* ws = wsG(a);
    constexpr int I_IN = 16 * 272, I_LRU = 8 * 8, I_DN = 48 * 32, I_PR = 16 * 32, I_PA = 8 * 32, I_WO = 16 * 32, I_UP = 16 * 192;
    const int total = ((mask & 1) ? I_IN : 0) + ((mask & 2) ? 2 * I_LRU : 0) + ((mask & 4) ? I_DN : 0) + ((mask & 8) ? (I_PR + I_PA + I_WO + I_UP) : 0);
    for (int it = gw; it < total; it += NGW) {
        int r = it;
        if (mask & 1) { if (r < I_IN) { transpose_item(inF(a, 3) + (size_t)l * DM * NIN, DM, NIN, (bf16_t*)(ws + WS_W1T), inF(a, 2) + l * DM, 1, scr, r, lane); continue; } r -= I_IN; }
        if (mask & 2) {
            if (r < I_LRU) { const int blk = r >> 3; transpose_item(inF(a, 6) + (size_t)l * 131072 + blk * 16384, 128, 128, (bf16_t*)(ws + WS_WAT) + blk * 16384, nullptr, 0, scr, r & 7, lane); continue; } r -= I_LRU;
            if (r < I_LRU) { const int blk = r >> 3; transpose_item(inF(a, 8) + (size_t)l * 131072 + blk * 16384, 128, 128, (bf16_t*)(ws + WS_WXT) + blk * 16384, nullptr, 0, scr, r & 7, lane); continue; } r -= I_LRU; }
        if (mask & 4) { if (r < I_DN) { transpose_item(inF(a, 20) + (size_t)l * DFF * DM, DFF, DM, (bf16_t*)(ws + WS_WDT), nullptr, 0, scr, r, lane); continue; } r -= I_DN; }
        if (mask & 8) {
            if (r < I_PR) { transpose_item(inF(a, 13) + (size_t)l * DM * DM, DM, DM, (bf16_t*)(ws + WS_PRT), nullptr, 0, scr, r, lane); continue; } r -= I_PR;
            if (r < I_PA) { transpose_item(inF(a, 14) + (size_t)l * 512 * DM, 512, DM, (bf16_t*)(ws + WS_PAT), nullptr, 0, scr, r, lane); continue; } r -= I_PA;
            if (r < I_WO) { transpose_item(inF(a, 15) + (size_t)l * DM * DM, DM, DM, (bf16_t*)(ws + WS_WOT), nullptr, 0, scr, r, lane); continue; } r -= I_WO;
            transpose_item(inF(a, 17) + (size_t)l * DM * NUP, DM, NUP, (bf16_t*)(ws + WS_WUT), inF(a, 16) + l * DM, 0, scr, r, lane); }
    }
}

DI void p0_rows(CArgsP a, int gw, int NGW, int lane) {
    const float* x = inF(a, 0); bf16_t* XB = (bf16_t*)(wsG(a) + WS_XB); float* ssp = (float*)(wsG(a) + WS_SSP);
    for (int m0 = 2 * gw; m0 < T; m0 += 2 * NGW) {
        const f32x4* xr0 = (const f32x4*)(x + (size_t)m0 * DM) + lane; const f32x4* xr1 = xr0 + DM / 4; f32x4 v[2][4]; float s0 = 0.f, s1 = 0.f;
#pragma unroll
        for (int j = 0; j < 4; ++j) { v[0][j] = __builtin_nontemporal_load(xr0 + 64 * j); v[1][j] = __builtin_nontemporal_load(xr1 + 64 * j); }
#pragma unroll
        for (int j = 0; j < 4; ++j) { s0 += (v[0][j].x * v[0][j].x + v[0][j].y * v[0][j].y) + (v[0][j].z * v[0][j].z + v[0][j].w * v[0][j].w);
                                      s1 += (v[1][j].x * v[1][j].x + v[1][j].y * v[1][j].y) + (v[1][j].z * v[1][j].z + v[1][j].w * v[1][j].w); }
#pragma unroll
        for (int o = 1; o < 64; o <<= 1) { s0 += __shfl_xor(s0, o); s1 += __shfl_xor(s1, o); }
        u32x2* o0 = (u32x2*)(XB + (size_t)m0 * DM) + lane; u32x2* o1 = o0 + DM / 4;
#pragma unroll
        for (int j = 0; j < 4; ++j) { u32x2 w; w.x = pk2(v[0][j].x, v[0][j].y); w.y = pk2(v[0][j].z, v[0][j].w); o0[64 * j] = w;
                                      u32x2 w1; w1.x = pk2(v[1][j].x, v[1][j].y); w1.y = pk2(v[1][j].z, v[1][j].w); o1[64 * j] = w1; }
        if (lane < 16) ssp[(size_t)m0 * 16 + lane] = (lane == 0) ? s0 : 0.f;
        else if (lane < 32) ssp[(size_t)(m0 + 1) * 16 + (lane - 16)] = (lane == 16) ? s1 : 0.f;
    }
}
DI void p0_rope(CArgsP a, int gtid, int nthr) {
    const int* pos = inI(a, 1); float* cosT = (float*)(wsG(a) + WS_COS); float* sinT = (float*)(wsG(a) + WS_SIN);
    for (int i = gtid; i < T * 64; i += nthr) {
        const int t = i >> 6, f = i & 63;
        const float inv = exp2f(-(float)f * (13.287712379549449f / 64.0f));
        const float ang = (float)pos[t] * inv;
        const double ad = (double)ang; const double kk = __builtin_rint(ad * 0.15915494309189535); const float r = (float)(ad - kk * 6.283185307179586);
        cosT[i] = __cosf(r); sinT[i] = __sinf(r);
    }
}

#define MFMA32(a, b, c) __builtin_amdgcn_mfma_f32_32x32x16_bf16((a), (b), (c), 0, 0, 0)
DI void lru_phase(CArgsP a, int l, LAS unsigned char* lds, int G, int tid, int wave, int lane) {
    unsigned char* ws = wsG(a);
    const bf16_t* XR = (const bf16_t*)(ws + WS_AR + AR_XR);
    LAS unsigned char* XCb = lds;
    LAS float* XCF = (LAS float*)(lds + 17408);
    LAS float* AA = (LAS float*)(lds + 17408 + 32768);
    const int cg8 = tid & 15, tr = tid >> 4;
    const int r = lane & 31, h = lane >> 5;
    const int cl = 16 * wave + (r & 15); const bool isI = r >= 16;
    int cur_n = -1;
    float w[4][8], bb[8]; bf16x8 bfr[8]; float bias = 0.f, sp8 = 0.f;
    unsigned long long pt0 = 0, pt1 = 0, pt2 = 0, pt3 = 0, pa0 = 0, pa1 = 0, pa2 = 0;
    u32x4 xv[2][4];
#define LRU_LOAD_XR(IT) do { const int b_ = (IT) >> 8, n_ = ((IT) >> 5) & 7, ck_ = (IT) & 31; const int c_ = n_ * 128 + 8 * cg8; \
        _Pragma("unroll") for (int j = 0; j < 2; ++j) _Pragma("unroll") for (int i = 0; i < 4; ++i) { const int p = ck_ * 64 + tr + 32 * j - 3 + i; \
            xv[j][i] = *(const u32x4*)(XR + (size_t)(b_ * SEQ + (p < 0 ? 0 : p)) * DM + c_); } } while (0)
    if ((int)blockIdx.x < 2048) LRU_LOAD_XR((int)blockIdx.x);
    for (int item = blockIdx.x; item < 2048; item += G) {
        const int b = item >> 8, n = (item >> 5) & 7, ck = item & 31;
        const int t0 = b * SEQ + ck * 64, c0 = n * 128;
        if (n != cur_n) {
            cur_n = n;
            const int c = c0 + 8 * cg8;
            const float* cw = inF(a, 4) + (size_t)l * 4 * DM + c; const float* cb = inF(a, 5) + (size_t)l * DM + c;
#pragma unroll
            for (int i = 0; i < 4; ++i) { const f32x4 w0 = *(const f32x4*)(cw + i * DM), w1 = *(const f32x4*)(cw + i * DM + 4);
#pragma unroll
                for (int e = 0; e < 4; ++e) { w[i][e] = w0[e]; w[i][4 + e] = w1[e]; } }
            { const f32x4 b0 = *(const f32x4*)cb, b1 = *(const f32x4*)(cb + 4);
#pragma unroll
              for (int e = 0; e < 4; ++e) { bb[e] = b0[e]; bb[4 + e] = b1[e]; } }
            const bf16_t* wrow = (r < 16) ? (const bf16_t*)(ws + WS_WAT) + n * 16384 + (16 * wave + r) * 128 : (const bf16_t*)(ws + WS_WXT) + n * 16384 + (16 * wave + r - 16) * 128;
#pragma unroll
            for (int ks = 0; ks < 8; ++ks) bfr[ks] = *(const bf16x8*)(wrow + 16 * ks + 8 * h);
            bias = isI ? (inF(a, 9))[(size_t)l * DM + c0 + cl] : (inF(a, 7))[(size_t)l * DM + c0 + cl];
            const float lam = (inF(a, 10))[(size_t)l * DM + c0 + cl];
            sp8 = 8.0f * log1pf(expf(-lam));
        }
        if (PROBE_SEL >= 0) pt0 = __builtin_amdgcn_s_memrealtime();
        {
#pragma unroll
            for (int j = 0; j < 2; ++j) { const int tl = tr + 32 * j, tp = ck * 64 + tl; float o[8];
#pragma unroll
                for (int e = 0; e < 8; ++e) o[e] = bb[e];
#pragma unroll
                for (int i = 0; i < 4; ++i) { const int p = tp - 3 + i; const float z = (p >= 0) ? 1.0f : 0.0f; const u32x4 v = xv[j][i];
                    o[0] += z * w[i][0] * bflo(v.x); o[1] += z * w[i][1] * bfhi(v.x); o[2] += z * w[i][2] * bflo(v.y); o[3] += z * w[i][3] * bfhi(v.y);
                    o[4] += z * w[i][4] * bflo(v.z); o[5] += z * w[i][5] * bfhi(v.z); o[6] += z * w[i][6] * bflo(v.w); o[7] += z * w[i][7] * bfhi(v.w); }
                *(LAS f32x4*)(XCF + tl * 128 + 8 * cg8) = (f32x4){o[0], o[1], o[2], o[3]}; *(LAS f32x4*)(XCF + tl * 128 + 8 * cg8 + 4) = (f32x4){o[4], o[5], o[6], o[7]};
                u32x4 pw; pw.x = pk2(o[0], o[1]); pw.y = pk2(o[2], o[3]); pw.z = pk2(o[4], o[5]); pw.w = pk2(o[6], o[7]);
                *(LAS u32x4*)(XCb + tl * 272 + 16 * cg8) = pw; }
            if (item + G < 2048) LRU_LOAD_XR(item + G);
        }
        __syncthreads();
        if (PROBE_SEL >= 0) pt1 = __builtin_amdgcn_s_memrealtime();
#pragma unroll
        for (int rt = 0; rt < 2; ++rt) {
            f32x16 acc;
#pragma unroll
            for (int i = 0; i < 16; ++i) acc[i] = 0.f;
#pragma unroll
            for (int ks = 0; ks < 8; ++ks) { const bf16x8 af = *(const LAS bf16x8*)(XCb + (32 * rt + r) * 272 + (16 * ks + 8 * h) * 2); acc = MFMA32(af, bfr[ks], acc); }
#pragma unroll
            for (int k = 0; k < 8; ++k) {
                const float g0 = sigmoidf_(acc[2 * k] + bias), g1 = sigmoidf_(acc[2 * k + 1] + bias);
                const float o0 = __shfl_xor(g0, 16), o1 = __shfl_xor(g1, 16);
                const float mine = isI ? g1 : g0, oth = isI ? o1 : o0;
                const float rg = isI ? oth : mine, ig = isI ? mine : oth;
                const int tl = 32 * rt + ((2 * k) & 3) + 8 * ((2 * k) >> 2) + 4 * h + (isI ? 1 : 0);
                const float la = -sp8 * rg;
                const float xv1 = XCF[tl * 128 + cl];
                AA[tl * 128 + cl] = fexp(la);
                XCF[tl * 128 + cl] = __builtin_amdgcn_sqrtf(one_minus_exp(2.0f * la)) * (ig * xv1); }
        }
        __syncthreads();
        if (PROBE_SEL >= 0) pt2 = __builtin_amdgcn_s_memrealtime();
        if (wave < 4) {
            const int cs = 32 * wave + (lane & 31), sg = lane >> 5; const int tb = 32 * sg;
            float A = 1.f, H = 0.f;
#pragma unroll 8
            for (int s2 = 0; s2 < 32; ++s2) { const float av = AA[(tb + s2) * 128 + cs], uv = XCF[(tb + s2) * 128 + cs]; H = av * H + uv; A *= av; }
            const float A0 = __shfl(A, lane & 31), H0 = __shfl(H, lane & 31);
            float hh = sg ? H0 : 0.f, Ac = sg ? A0 : 1.f;
            unsigned* HL = (unsigned*)(ws + WS_AR + AR_HL) + (size_t)(t0 + tb) * DM + c0 + cs;
#pragma unroll 8
            for (int s2 = 0; s2 < 32; ++s2) { const float av = AA[(tb + s2) * 128 + cs], uv = XCF[(tb + s2) * 128 + cs]; hh = av * hh + uv; Ac *= av; __builtin_nontemporal_store(pkh2(hh, Ac), HL + (size_t)s2 * DM); }
            if (sg) { ((float*)(ws + WS_AGGA))[(size_t)(b * 32 + ck) * DM + c0 + cs] = Ac; ((float*)(ws + WS_AGGH))[(size_t)(b * 32 + ck) * DM + c0 + cs] = hh; }
        }
        __syncthreads();
        if (PROBE_SEL >= 0) { pt3 = __builtin_amdgcn_s_memrealtime(); pa0 += pt1 - pt0; pa1 += pt2 - pt1; pa2 += pt3 - pt2; }
    }
    if (PROBE_SEL >= 0 && blockIdx.x == 0 && tid == 0) { unsigned long long* TSP = (unsigned long long*)(ws + WS_CTL + 512 * 1024); TSP[96] += pa0; TSP[97] += pa1; TSP[98] += pa2; }
}

DI bf16x8 pack8(const f32x16& x, int s) {
    u32x4 p; p.x = pk2(x[8 * s], x[8 * s + 1]); p.y = pk2(x[8 * s + 2], x[8 * s + 3]); p.z = pk2(x[8 * s + 4], x[8 * s + 5]); p.w = pk2(x[8 * s + 6], x[8 * s + 7]);
    return __builtin_bit_cast(bf16x8, p);
}
DI void attn_item(unsigned char* ws, LAS unsigned char* wl  , int hd, int b, int qi, int qi0  , int lane) {
    const bf16_t* Q = (const bf16_t*)(ws + WS_AR + AR_Q); const bf16_t* Kp = (const bf16_t*)(ws + WS_AR + AR_K); const bf16_t* V = (const bf16_t*)(ws + WS_AR + AR_V);
    bf16_t* OG = (bf16_t*)(ws + WS_AR + AR_OG); float* LSE = (float*)(ws + WS_LSE);
    const int sh = 2 * (hd >> 2), tps = 64 >> sh;
    const int rstream = qi / tps, m0 = 32 * (qi % tps);
    const int r = lane & 31, h = lane >> 5;
    const int lrow = lane >> 4, lch = lane & 15;
    LAS unsigned char* KL = wl; LAS unsigned char* VL = wl + 8704;
    const size_t qtok = (size_t)b * SEQ + ((size_t)(m0 + r) << sh) + rstream;
    const int kt0 = (m0 >= 128) ? 0 : (4 - (m0 >> 5));
    const size_t tstride = ((size_t)32 << sh) * AW, rstride = ((size_t)4 << sh) * AW;
    const size_t stok0 = (size_t)b * SEQ + ((size_t)(m0 - 128 + 32 * kt0 + lrow) << sh) + rstream;
    const bf16_t* kg = Kp + stok0 * AW + hd * 128 + 8 * lch; const bf16_t* vg = V + stok0 * AW + hd * 128 + 8 * lch;
    u32x4 ks_[8], vs_[8];
#pragma unroll
    for (int i = 0; i < 8; ++i) ks_[i] = *(const u32x4*)(kg + (size_t)i * rstride);
#pragma unroll
    for (int i = 0; i < 8; ++i) vs_[i] = *(const u32x4*)(vg + (size_t)i * rstride);
    const bf16_t* qrow = Q + qtok * AW + hd * 128 + 8 * h;
    bf16x8 qf[8];
#pragma unroll
    for (int ks = 0; ks < 8; ++ks) qf[ks] = *(const bf16x8*)(qrow + 16 * ks);
    bf16x8 idf[2];
#pragma unroll
    for (int e = 0; e < 2; ++e)
#pragma unroll
        for (int j = 0; j < 8; ++j) idf[e][j] = (16 * e + 8 * h + j == r) ? (short)0x3F80 : (short)0;
    f32x16 O[4];
#pragma unroll
    for (int dt = 0; dt < 4; ++dt)
#pragma unroll
        for (int i = 0; i < 16; ++i) O[dt][i] = 0.f;
    float mrun = -1e30f, lpart = 0.f;
    constexpr float L2E = 1.4426950408889634f;
    const int woff = lrow * 272 + lch * 16, roff = r * 272 + h * 16;
    const int trb = (4 * h + ((lane & 15) >> 2)) * 272 + (16 * (r >> 4) + 4 * (lane & 3)) * 2;
    const int dq = 0, nsteps = 5; (void)qi0;
    for (int st = 0; st < nsteps; ++st) {
        const int kt = st + dq;
        if (kt >= kt0 && kt < 5) {
#pragma unroll
        for (int i = 0; i < 8; ++i) { *(LAS u32x4*)(KL + woff + i * 1088) = ks_[i]; *(LAS u32x4*)(VL + woff + i * 1088) = vs_[i]; }
        if (kt < 4) { kg += tstride; vg += tstride;
#pragma unroll
            for (int i = 0; i < 8; ++i) ks_[i] = *(const u32x4*)(kg + (size_t)i * rstride);
#pragma unroll
            for (int i = 0; i < 8; ++i) vs_[i] = *(const u32x4*)(vg + (size_t)i * rstride); }
        f32x16 Sx;
#pragma unroll
        for (int i = 0; i < 16; ++i) Sx[i] = 0.f;
        __builtin_amdgcn_s_setprio(1);
#pragma unroll
        for (int ks = 0; ks < 8; ++ks) { const bf16x8 kf = *(const LAS bf16x8*)(KL + roff + 32 * ks); Sx = MFMA32(kf, qf[ks], Sx); }
        __builtin_amdgcn_s_setprio(0);
        float mx = -1e30f;
        if (kt == 0 || kt == 4) {
#pragma unroll
            for (int i = 0; i < 16; ++i) { const int ki = (i & 3) + 8 * (i >> 2) + 4 * h;
                if ((kt == 0 && ki < r) || (kt == 4 && ki > r)) Sx[i] = -1e30f; } }
#pragma unroll
        for (int i = 0; i < 16; ++i) mx = fmaxf(mx, Sx[i]);
        mx = fmaxf(mx, __shfl_xor(mx, 32));
        const float mnew = fmaxf(mrun, mx), alpha = __builtin_amdgcn_exp2f((mrun - mnew) * L2E);
        float ps = 0.f;
#pragma unroll
        for (int i = 0; i < 16; ++i) { Sx[i] = __builtin_amdgcn_exp2f((Sx[i] - mnew) * L2E); ps += Sx[i]; }
        const bool any_grow = __builtin_amdgcn_ballot_w64(mnew > mrun) != 0ull;
        lpart = lpart * alpha + ps; mrun = mnew;
        const bf16x8 pf0 = pack8(Sx, 0), pf1 = pack8(Sx, 1);
#pragma unroll
        for (int dt = 0; dt < 4; ++dt) {
            const LAS unsigned char* tb = VL + trb + 64 * dt;
            const s16x4 a00 = __builtin_amdgcn_ds_read_tr16_b64_v4i16((LAS s16x4*)(tb)), a01 = __builtin_amdgcn_ds_read_tr16_b64_v4i16((LAS s16x4*)(tb + 8 * 272));
            const s16x4 a10 = __builtin_amdgcn_ds_read_tr16_b64_v4i16((LAS s16x4*)(tb + 16 * 272)), a11 = __builtin_amdgcn_ds_read_tr16_b64_v4i16((LAS s16x4*)(tb + 24 * 272));
            const bf16x8 xf0 = __builtin_shufflevector(a00, a01, 0, 1, 2, 3, 4, 5, 6, 7), xf1 = __builtin_shufflevector(a10, a11, 0, 1, 2, 3, 4, 5, 6, 7);
            if (any_grow) {
#pragma unroll
            for (int i = 0; i < 16; ++i) O[dt][i] *= alpha; }
            __builtin_amdgcn_s_setprio(1); O[dt] = MFMA32(xf0, pf0, O[dt]); O[dt] = MFMA32(xf1, pf1, O[dt]); __builtin_amdgcn_s_setprio(0);
        }
        }
        __builtin_amdgcn_s_barrier();
    }
    const float ltot = lpart + __shfl_xor(lpart, 32), inv = frcp(ltot);
    bf16_t* orow = OG + qtok * AW + hd * 128 + 4 * h;
#pragma unroll
    for (int dt = 0; dt < 4; ++dt)
#pragma unroll
        for (int gq = 0; gq < 4; ++gq) { u32x2 w; w.x = pk2(O[dt][4 * gq] * inv, O[dt][4 * gq + 1] * inv); w.y = pk2(O[dt][4 * gq + 2] * inv, O[dt][4 * gq + 3] * inv);
            *(u32x2*)(orow + 32 * dt + 8 * gq) = w; }
    if (h == 0) LSE[qtok * 12 + hd] = mrun + logf(ltot);
}

DI void b2_fix(CArgsP a, int tid) {
    unsigned char* ws = wsG(a);
    const float* AGA = (const float*)(ws + WS_AGGA); const float* AGH = (const float*)(ws + WS_AGGH);
    const unsigned* HL = (const unsigned*)(ws + WS_AR + AR_HL); const bf16_t* GG = (const bf16_t*)(ws + WS_AR + AR_GG); bf16_t* YR = (bf16_t*)(ws + WS_AR + AR_YR);
    for (int it = blockIdx.x; it < 256; it += gridDim.x) {
        const int b = it >> 5, ck = it & 31, c = 4 * (tid & 255), th = tid >> 8;
        f32x4 carry = {0.f, 0.f, 0.f, 0.f};
        {
            const float* pa = AGA + (size_t)(b * 32) * DM + c; const float* ph = AGH + (size_t)(b * 32) * DM + c;
            int j = 0;
            for (; j + 8 <= ck; j += 8) { f32x4 A[8], H[8];
#pragma unroll
                for (int e = 0; e < 8; ++e) { A[e] = *(const f32x4*)(pa + (size_t)(j + e) * DM); H[e] = *(const f32x4*)(ph + (size_t)(j + e) * DM); }
#pragma unroll
                for (int e = 0; e < 8; ++e) carry = A[e] * carry + H[e]; }
            for (; j < ck; ++j) { const f32x4 A = *(const f32x4*)(pa + (size_t)j * DM), H = *(const f32x4*)(ph + (size_t)j * DM); carry = A * carry + H; }
        }
        const size_t tb = (size_t)b * SEQ + ck * 64 + 32 * th;
#pragma unroll 4
        for (int s = 0; s < 32; ++s) { const size_t off = (tb + s) * DM + c;
            const u32x4 hl = __builtin_nontemporal_load((const u32x4*)(HL + off)); const u32x2 gg = __builtin_nontemporal_load((const u32x2*)(GG + off));
            const float y0 = (hlo(hl.x) + hhi(hl.x) * carry[0]) * bflo(gg.x), y1 = (hlo(hl.y) + hhi(hl.y) * carry[1]) * bfhi(gg.x);
            const float y2 = (hlo(hl.z) + hhi(hl.z) * carry[2]) * bflo(gg.y), y3 = (hlo(hl.w) + hhi(hl.w) * carry[3]) * bfhi(gg.y);
            u32x2 w; w.x = pk2(y0, y1); w.y = pk2(y2, y3); *(u32x2*)(YR + off) = w; }
    }
}
DI void b2_merge(unsigned char* ws, int gtid, int nthr) {
    const bf16_t* OG = (const bf16_t*)(ws + WS_AR + AR_OG); const float* LSE = (const float*)(ws + WS_LSE); bf16_t* YA = (bf16_t*)(ws + WS_AR + AR_YA);
    for (int i = gtid; i < T * 64; i += nthr) {
        const int t = i >> 6, j = (i >> 4) & 3, d8 = i & 15;
        const float l0 = LSE[(size_t)t * 12 + j], l1 = LSE[(size_t)t * 12 + 4 + j], l2 = LSE[(size_t)t * 12 + 8 + j];
        const float mx = fmaxf(l0, fmaxf(l1, l2)); const float e0 = fexp(l0 - mx), e1 = fexp(l1 - mx), e2 = fexp(l2 - mx); const float inv = frcp(e0 + e1 + e2);
        const float w0 = e0 * inv, w1 = e1 * inv, w2 = e2 * inv;
        const bf16_t* op = OG + (size_t)t * AW + j * 128 + 8 * d8;
        const u32x4 o0 = __builtin_nontemporal_load((const u32x4*)op), o1 = __builtin_nontemporal_load((const u32x4*)(op + 512)), o2 = __builtin_nontemporal_load((const u32x4*)(op + 1024));
        u32x4 w;
        w.x = pk2(w0 * bflo(o0.x) + w1 * bflo(o1.x) + w2 * bflo(o2.x), w0 * bfhi(o0.x) + w1 * bfhi(o1.x) + w2 * bfhi(o2.x));
        w.y = pk2(w0 * bflo(o0.y) + w1 * bflo(o1.y) + w2 * bflo(o2.y), w0 * bfhi(o0.y) + w1 * bfhi(o1.y) + w2 * bfhi(o2.y));
        w.z = pk2(w0 * bflo(o0.z) + w1 * bflo(o1.z) + w2 * bflo(o2.z), w0 * bfhi(o0.z) + w1 * bfhi(o1.z) + w2 * bfhi(o2.z));
        w.w = pk2(w0 * bflo(o0.w) + w1 * bflo(o1.w) + w2 * bflo(o2.w), w0 * bfhi(o0.w) + w1 * bfhi(o1.w) + w2 * bfhi(o2.w));
        *(u32x4*)(YA + (size_t)t * 512 + j * 128 + 8 * d8) = w;
    }
}

DI void e2_convact(CArgsP a, int l, int gtid, int nthr) {
    unsigned char* ws = wsG(a);
    const bf16_t* U = (const bf16_t*)(ws + WS_AR + AR_U); bf16_t* ACT = (bf16_t*)(ws + WS_AR + AR_ACT);
    const float* cw = inF(a, 18) + (size_t)l * 3 * NUP; const float* cb = inF(a, 19) + (size_t)l * NUP;
    for (int i = gtid; i < 1024 * 384; i += nthr) {
        const int c8 = i % 384, run = i / 384, c = 8 * c8; const int tstart = run * 16, p0 = tstart & (SEQ - 1);
        float wg[3][8], wv[3][8], bg[8], bv[8];
#pragma unroll
        for (int k = 0; k < 3; ++k) { const f32x4 g0 = *(const f32x4*)(cw + k * NUP + c), g1 = *(const f32x4*)(cw + k * NUP + c + 4), v0 = *(const f32x4*)(cw + k * NUP + DFF + c), v1 = *(const f32x4*)(cw + k * NUP + DFF + c + 4);
#pragma unroll
            for (int e = 0; e < 4; ++e) { wg[k][e] = g0[e]; wg[k][4 + e] = g1[e]; wv[k][e] = v0[e]; wv[k][4 + e] = v1[e]; } }
        { const f32x4 g0 = *(const f32x4*)(cb + c), g1 = *(const f32x4*)(cb + c + 4), v0 = *(const f32x4*)(cb + DFF + c), v1 = *(const f32x4*)(cb + DFF + c + 4);
#pragma unroll
          for (int e = 0; e < 4; ++e) { bg[e] = g0[e]; bg[4 + e] = g1[e]; bv[e] = v0[e]; bv[4 + e] = v1[e]; } }
        float g2[8], g1r[8], v2[8], v1r[8];
#pragma unroll
        for (int e = 0; e < 8; ++e) { g2[e] = 0.f; g1r[e] = 0.f; v2[e] = 0.f; v1r[e] = 0.f; }
        if (p0 >= 2) {
            const u32x4 ga = *(const u32x4*)(U + (size_t)(tstart - 2) * NUP + c), gb = *(const u32x4*)(U + (size_t)(tstart - 1) * NUP + c);
            const u32x4 va = *(const u32x4*)(U + (size_t)(tstart - 2) * NUP + DFF + c), vb = *(const u32x4*)(U + (size_t)(tstart - 1) * NUP + DFF + c);
            g2[0] = bflo(ga.x); g2[1] = bfhi(ga.x); g2[2] = bflo(ga.y); g2[3] = bfhi(ga.y); g2[4] = bflo(ga.z); g2[5] = bfhi(ga.z); g2[6] = bflo(ga.w); g2[7] = bfhi(ga.w);
            g1r[0] = bflo(gb.x); g1r[1] = bfhi(gb.x); g1r[2] = bflo(gb.y); g1r[3] = bfhi(gb.y); g1r[4] = bflo(gb.z); g1r[5] = bfhi(gb.z); g1r[6] = bflo(gb.w); g1r[7] = bfhi(gb.w);
            v2[0] = bflo(va.x); v2[1] = bfhi(va.x); v2[2] = bflo(va.y); v2[3] = bfhi(va.y); v2[4] = bflo(va.z); v2[5] = bfhi(va.z); v2[6] = bflo(va.w); v2[7] = bfhi(va.w);
            v1r[0] = bflo(vb.x); v1r[1] = bfhi(vb.x); v1r[2] = bflo(vb.y); v1r[3] = bfhi(vb.y); v1r[4] = bflo(vb.z); v1r[5] = bfhi(vb.z); v1r[6] = bflo(vb.w); v1r[7] = bfhi(vb.w);
        }
#pragma unroll 4
        for (int s = 0; s < 16; ++s) {
            const u32x4 gc = __builtin_nontemporal_load((const u32x4*)(U + (size_t)(tstart + s) * NUP + c)), vc = __builtin_nontemporal_load((const u32x4*)(U + (size_t)(tstart + s) * NUP + DFF + c));
            float g0[8], v0[8];
            g0[0] = bflo(gc.x); g0[1] = bfhi(gc.x); g0[2] = bflo(gc.y); g0[3] = bfhi(gc.y); g0[4] = bflo(gc.z); g0[5] = bfhi(gc.z); g0[6] = bflo(gc.w); g0[7] = bfhi(gc.w);
            v0[0] = bflo(vc.x); v0[1] = bfhi(vc.x); v0[2] = bflo(vc.y); v0[3] = bfhi(vc.y); v0[4] = bflo(vc.z); v0[5] = bfhi(vc.z); v0[6] = bflo(vc.w); v0[7] = bfhi(vc.w);
            float o[8];
#pragma unroll
            for (int e = 0; e < 8; ++e) { const float ug = bg[e] + wg[0][e] * g2[e] + wg[1][e] * g1r[e] + wg[2][e] * g0[e]; const float uv = bv[e] + wv[0][e] * v2[e] + wv[1][e] * v1r[e] + wv[2][e] * v0[e];
                o[e] = gelu_tanh(ug) * uv; g2[e] = g1r[e]; g1r[e] = g0[e]; v2[e] = v1r[e]; v1r[e] = v0[e]; }
            u32x4 w; w.x = pk2(o[0], o[1]); w.y = pk2(o[2], o[3]); w.z = pk2(o[4], o[5]); w.w = pk2(o[6], o[7]);
            *(u32x4*)(ACT + (size_t)(tstart + s) * DFF + c) = w;
        }
    }
}

constexpr int NPHASE = 1 + 8 * DEPTH;
__global__ void __launch_bounds__(512, 2) mega(Args a_byval) {
    CArgsP a0 = (CArgsP)__builtin_amdgcn_kernarg_segment_ptr(); CArgsP a = a0;
    extern __shared__ __attribute__((aligned(16))) unsigned char lds_raw[];
    LAS unsigned char* lds = (LAS unsigned char*)lds_raw;
    unsigned char* ws0 = wsG(a);
    volatile LAS unsigned* MISC = (volatile LAS unsigned*)(lds + MISC_OFF);
    if (threadIdx.x < 64) MISC[threadIdx.x] = 0u;
    __syncthreads();
    XcdBarrier bar; bar.bar = (unsigned*)(ws0 + WS_CTL); bar.x = 0; bar.st = MISC + 8;
    if (a->coop && !USE_CG_SYNC) bar = xcd_barrier_post((unsigned*)(ws0 + WS_CTL), MISC + 8);

    unsigned long long* TS = (unsigned long long*)(ws0 + WS_CTL + 512 * 1024);
    if (PROBE_SEL >= 0 && blockIdx.x == 0 && threadIdx.x == 0) TS[0] = __builtin_amdgcn_s_memrealtime();
    for (int ph = a->ph_lo; ph < a->ph_hi; ++ph) {
        a = a0; asm volatile("" : "+s"(a));
        GAS1 unsigned char* wsg = (GAS1 unsigned char*)a->ws; asm volatile("" : "+s"(wsg)); unsigned char* ws = (unsigned char*)wsg;
        int bid = blockIdx.x; asm volatile("" : "+s"(bid));
        int G = gridDim.x; asm volatile("" : "+s"(G));
        const int NGW = G * 8, nthr = G * 512;
        int tid = threadIdx.x; asm volatile("" : "+v"(tid));
        const int lane = tid & 63, wave = __builtin_amdgcn_readfirstlane(tid >> 6);
        const int gw = bid * 8 + wave, gtid = bid * 512 + tid;
        if (ph == 0) {
          if (PHASE_MASK & 1) {
            convert_weights(a, 0, (G == 256) ? 7 : 15, lds, gw, NGW, wave, lane);
            p0_rows(a, gw, NGW, lane);
            p0_rope(a, gtid, nthr);
          }
        } else {
            const int l = (ph - 1) >> 3, sub = (ph - 1) & 7;
            float* xout = outF(a);
            bf16_t* XB = (bf16_t*)(ws + WS_XB); float* ssp = (float*)(ws + WS_SSP);
            if (sub == 0 && (PHASE_MASK & 2)) {
                pg8::Gemm g{XB, (const bf16_t*)(ws + WS_W1T), T, NIN, DM}; pg8::StaticOrder S; S.init(T, NIN, G, bid);
                pg8::EpiIn E{ssp, (bf16_t*)(ws + WS_AR + AR_XR), (bf16_t*)(ws + WS_AR + AR_GG), (bf16_t*)(ws + WS_AR + AR_SGR), (bf16_t*)(ws + WS_AR + AR_SGA),
                             (bf16_t*)(ws + WS_AR + AR_Q), (bf16_t*)(ws + WS_AR + AR_K), (bf16_t*)(ws + WS_AR + AR_V),
                             inF(a, 11) + (size_t)l * AW, inF(a, 12) + (size_t)l * AW, (const float*)(ws + WS_COS), (const float*)(ws + WS_SIN), (LAS float*)(lds + TAB_OFF)};
                pg8::gemm_phase(lds, g, S, E);
                if (G == 256 && bid >= 128) convert_weights(a, l, 8, lds, (bid - 128) * 8 + wave, 128 * 8, wave, lane);
            } else if (sub == 1 && (PHASE_MASK & 4)) {
                const bool attn_first = ((bid >> 3) & 1) != 0;
                if (!attn_first) lru_phase(a, l, lds, G, tid, wave, lane);
                unsigned long long tp0 = 0, tp1 = 0;
                if (PROBE_SEL >= 0) { __syncthreads(); tp0 = __builtin_amdgcn_s_memrealtime(); if (threadIdx.x == 0) { atomicMax((unsigned*)(TS + 80 + l), (unsigned)(tp0 - TS[1 + 8 * l + 1])); if (blockIdx.x == 0) TS[64 + l] = tp0; } }
                for (int u = bid; u < 768; u += G) attn_item(ws, lds + wave * 17408, u >> 6, (u >> 3) & 7, 8 * (u & 7) + wave, 8 * (u & 7), lane);
                if (attn_first) { __syncthreads(); lru_phase(a, l, lds, G, tid, wave, lane); }
                if (PROBE_SEL >= 0) { __syncthreads(); tp1 = __builtin_amdgcn_s_memrealtime(); if (threadIdx.x == 0) { atomicMax((unsigned*)(TS + 88 + l), (unsigned)(tp1 - tp0)); if (blockIdx.x == 0) TS[72 + l] = tp1; } }
            } else if (sub == 2 && (PHASE_MASK & 8)) {
                b2_fix(a, tid);
                b2_merge(ws, gtid, nthr);
                if (l + 1 < DEPTH) convert_weights(a, l + 1, 3, lds, gw, NGW, wave, lane);
                if (l >= 1) convert_weights(a, l, 4, lds, gw, NGW, wave, lane);
            } else if (sub == 3 && (PHASE_MASK & 16)) {
                { pg8::Gemm g{(const bf16_t*)(ws + WS_AR + AR_YR), (const bf16_t*)(ws + WS_PRT), T, DM, DM}; pg8::StaticOrder S; S.init(T, DM, G, bid);
                  pg8::EpiProj1 E{(const bf16_t*)(ws + WS_AR + AR_SGR), (bf16_t*)(ws + WS_AR + AR_TMP)}; pg8::gemm_phase(lds, g, S, E); }
                { pg8::Gemm g{(const bf16_t*)(ws + WS_AR + AR_YA), (const bf16_t*)(ws + WS_PAT), T, DM, 512}; pg8::StaticOrder S; S.init(T, DM, G, bid);
                  pg8::EpiProj2 E{(const bf16_t*)(ws + WS_AR + AR_SGA), (const bf16_t*)(ws + WS_AR + AR_TMP), (bf16_t*)(ws + WS_AR + AR_MG)}; pg8::gemm_phase(lds, g, S, E); }
            } else if (sub == 4 && (PHASE_MASK & 32)) {
                pg8::Gemm g{(const bf16_t*)(ws + WS_AR + AR_MG), (const bf16_t*)(ws + WS_WOT), T, DM, DM}; pg8::StaticOrder S; S.init(T, DM, G, bid);
                pg8::EpiResid E{xout, XB, ssp, 0}; pg8::gemm_phase(lds, g, S, E);
            } else if (sub == 5 && (PHASE_MASK & 64)) {
                pg8::Gemm g{XB, (const bf16_t*)(ws + WS_WUT), T, NUP, DM}; pg8::StaticOrder S; S.init(T, NUP, G, bid);
                pg8::EpiUp E{ssp, (bf16_t*)(ws + WS_AR + AR_U)}; pg8::gemm_phase(lds, g, S, E);
            } else if (sub == 6 && (PHASE_MASK & 128)) {
                e2_convact(a, l, gtid, nthr);
                if (l + 1 < DEPTH && G != 256) convert_weights(a, l + 1, 8, lds, gw, NGW, wave, lane);
            } else if (sub == 7 && (PHASE_MASK & 256)) {
                pg8::Gemm g{(const bf16_t*)(ws + WS_AR + AR_ACT), (const bf16_t*)(ws + WS_WDT), T, DM, DFF}; pg8::StaticOrder S; S.init(T, DM, G, bid);
                pg8::EpiResid E{xout, XB, ssp, (l == DEPTH - 1) ? 1 : 0}; pg8::gemm_phase(lds, g, S, E);
            }
        }
        if (ph + 1 < a->ph_hi || PROBE_SEL >= 0) {
            if (USE_CG_SYNC || a->coop == 2) { cg::this_grid().sync(); }
            else xcd_barrier(bar);
        }
        if (PROBE_SEL >= 0 && blockIdx.x == 0 && threadIdx.x == 0) TS[ph + 1] = __builtin_amdgcn_s_memrealtime();
    }
    if (PROBE_SEL >= 0) {
        xcd_barrier(bar);
        unsigned long long tot = 0;
        if (PROBE_SEL < 8) { for (int l = 0; l < DEPTH; ++l) tot += TS[2 + 8 * l + PROBE_SEL] - TS[1 + 8 * l + PROBE_SEL]; }
        else if (PROBE_SEL == 8) tot = TS[1] - TS[0];
        else if (PROBE_SEL == 10) { for (int l = 0; l < DEPTH; ++l) tot += TS[64 + l] - TS[2 + 8 * l]; }
        else if (PROBE_SEL == 11) { for (int l = 0; l < DEPTH; ++l) tot += TS[72 + l] - TS[64 + l]; }
        else if (PROBE_SEL >= 14 && PROBE_SEL <= 16) tot = TS[96 + PROBE_SEL - 14];
        else if (PROBE_SEL == 12) { for (int l = 0; l < DEPTH; ++l) tot += (unsigned)TS[80 + l]; }
        else if (PROBE_SEL == 13) { for (int l = 0; l < DEPTH; ++l) tot += (unsigned)TS[88 + l]; }
        else tot = TS[NPHASE] - TS[0];
        const float v = (float)tot * 0.001f;
        if (blockIdx.x == 0 && threadIdx.x == 0) outF(a)[0] += v;
    }
}

extern "C" void kernel_launch(void* const* d_in, const int* in_sizes, int n_in, void* d_out, int out_size, void* d_ws, size_t ws_size, hipStream_t stream) {
    static int grid = 0;
    if (grid == 0) {
        if (n_in != 21 || out_size != T * DM || ws_size < WS_END) { fprintf(stderr, "kernel_launch: unexpected shapes (n_in %d out %d ws %zu, need %zu)\n", n_in, out_size, ws_size, (size_t)WS_END); grid = -1; return; }
        int dev = 0, cus = 0, per_cu = 0;
        hipGetDevice(&dev); hipDeviceGetAttribute(&cus, hipDeviceAttributeMultiprocessorCount, dev);
        if (hipFuncSetAttribute((const void*)mega, hipFuncAttributeMaxDynamicSharedMemorySize, LDS_BYTES) != hipSuccess) { fprintf(stderr, "kernel_launch: hipFuncSetAttribute failed\n"); grid = -1; return; }
        if (hipOccupancyMaxActiveBlocksPerMultiprocessor(&per_cu, (const void*)mega, 512, LDS_BYTES) != hipSuccess || per_cu < 1) { fprintf(stderr, "kernel_launch: occupancy query says %d\n", per_cu); per_cu = 1; }
        (void)hipGetLastError();
        grid = cus * 1;
        fprintf(stderr, "kernel_launch: grid %d (cus %d, per_cu %d)\n", grid, cus, per_cu);
    }
    if (grid < 0) return;
    Args a{};
    for (int i = 0; i < 21; ++i) a.in[i] = d_in[i];
    a.out = (float*)d_out; a.ws = (unsigned char*)d_ws; a.pad = 0;
    hipMemsetAsync((char*)d_ws + WS_CTL, 0, (PROBE_SEL >= 0) ? CTL_BYTES : (size_t)65536, stream);
#if MK_MULTI
    for (int p = 0; p < DBG_NPH; ++p) { a.ph_lo = p; a.ph_hi = p + 1; a.coop = 0; hipLaunchKernelGGL(mega, dim3(grid), dim3(512), LDS_BYTES, stream, a); }
#else
    a.ph_lo = 0; a.ph_hi = NPHASE; a.coop = 1;
    void* args[] = {&a};
    hipError_t e = hipLaunchCooperativeKernel((const void*)mega, dim3(grid), dim3(512), args, LDS_BYTES, stream);
    if (e != hipSuccess) fprintf(stderr, "kernel_launch: cooperative launch failed: %s (grid %d)\n", hipGetErrorString(e), grid);
#endif
}
```

```cpp
#include <hip/hip_runtime.h>
#include <hip/hip_cooperative_groups.h>
#include <cstdio>
namespace cg = cooperative_groups;

#ifndef MK_MULTI
#define MK_MULTI 0
#endif
#ifndef PHASE_MASK
#define PHASE_MASK 0x1ff
#endif
#ifndef PROBE_SEL
#define PROBE_SEL -1
#endif
#ifndef DBG_NPH
#define DBG_NPH 33
#endif
#ifndef USE_CG_SYNC
#define USE_CG_SYNC 0
#endif

#define DI __device__ __forceinline__
#define LAS __attribute__((address_space(3)))
typedef unsigned short bf16_t;
typedef short bf16x8 __attribute__((ext_vector_type(8)));
typedef float f32x2 __attribute__((ext_vector_type(2)));
typedef float f32x4 __attribute__((ext_vector_type(4)));
typedef float f32x16 __attribute__((ext_vector_type(16)));
typedef unsigned u32x2 __attribute__((ext_vector_type(2)));
typedef unsigned u32x4 __attribute__((ext_vector_type(4)));
typedef __bf16 bf16x2v __attribute__((ext_vector_type(2)));
typedef short s16x4 __attribute__((ext_vector_type(4)));

constexpr int T = 16384, SEQ = 2048, NBATCH = 8, DEPTH = 4;
constexpr int DM = 1024, NIN = 8704, AW = 1536, DFF = 3072, NUP = 6144;
constexpr float EPS = 1e-6f;

constexpr size_t MiB = 1u << 20;
constexpr size_t WS_CTL = 0, CTL_BYTES = 1 * MiB;
constexpr size_t WS_SSP = 1 * MiB;
constexpr size_t WS_AGGA = 2 * MiB, WS_AGGH = 3 * MiB;
constexpr size_t WS_LSE = 4 * MiB;
constexpr size_t WS_COS = 5 * MiB, WS_SIN = 9 * MiB;
constexpr size_t WS_W1T = 13 * MiB;
constexpr size_t WS_WUT = 30 * MiB;
constexpr size_t WS_WDT = 42 * MiB;
constexpr size_t WS_PRT = 48 * MiB;
constexpr size_t WS_PAT = 50 * MiB;
constexpr size_t WS_WOT = 51 * MiB;
constexpr size_t WS_WAT = 53 * MiB;
constexpr size_t WS_WXT = 53 * MiB + 262144;
constexpr size_t WS_XB = 54 * MiB;
constexpr size_t WS_AR = 86 * MiB;
constexpr size_t AR_XR = 0, AR_YR = 0;
constexpr size_t AR_GG = 32 * MiB, AR_MG = 32 * MiB;
constexpr size_t AR_SGR = 64 * MiB, AR_SGA = 96 * MiB;
constexpr size_t AR_Q = 128 * MiB, AR_K = 176 * MiB, AR_V = 224 * MiB;
constexpr size_t AR_YA = 128 * MiB, AR_TMP = 144 * MiB;
constexpr size_t AR_HL = 272 * MiB, AR_OG = 336 * MiB;
constexpr size_t AR_U = 0, AR_ACT = 192 * MiB;
constexpr size_t WS_END = WS_AR + 384 * MiB;

constexpr int RING_BYTES = 131072;
constexpr int TAB_OFF = RING_BYTES;
constexpr int MISC_OFF = RING_BYTES + 8192;
constexpr int LDS_BYTES = 147456;

#define LDS_WAIT() asm volatile("s_waitcnt lgkmcnt(0)" ::: "memory")
DI unsigned f2bf(float f) { unsigned u = __builtin_bit_cast(unsigned, f); return (u + 0x7fffu + ((u >> 16) & 1u)) >> 16; }
DI unsigned pk2(float lo, float hi) { f32x2 v = {lo, hi}; return __builtin_bit_cast(unsigned, __builtin_convertvector(v, bf16x2v)); }
DI float bflo(unsigned w) { return __builtin_bit_cast(float, w << 16); }
DI float bfhi(unsigned w) { return __builtin_bit_cast(float, w & 0xffff0000u); }
DI float frcp(float x) { return __builtin_amdgcn_rcpf(x); }
DI float fexp(float x) { return __builtin_amdgcn_exp2f(x * 1.4426950408889634f); }
DI float sigmoidf_(float x) { return frcp(1.0f + fexp(-x)); }
DI float gelu_tanh(float x) { const float y = 1.5957691216057308f * (x + 0.044715f * x * x * x); return x * frcp(1.0f + fexp(-y)); }
DI float one_minus_exp(float y) { const float ser = -y * (1.0f + y * (0.5f + y * (0.16666667f + y * (0.041666668f + y * (0.0083333333f + y * 0.0013888889f))))); return (y > -0.3f) ? ser : (1.0f - fexp(y)); }
DI unsigned pkh2(float lo, float hi) { const _Float16 a = (_Float16)lo, b = (_Float16)hi; return (unsigned)__builtin_bit_cast(unsigned short, a) | ((unsigned)__builtin_bit_cast(unsigned short, b) << 16); }
DI float hlo(unsigned w) { return (float)__builtin_bit_cast(_Float16, (unsigned short)(w & 0xffffu)); }
DI float hhi(unsigned w) { return (float)__builtin_bit_cast(_Float16, (unsigned short)(w >> 16)); }

namespace pg8 {
constexpr int BM = 256, BK = 64, HALF = 128, HTB = HALF * BK * 2, NXCD = 8, WGM = 4;
DI int lds_byte(int r, int c) { const int st = (r >> 4) * 2 + (c >> 5), rr = r & 15, cc = c & 31, ob = rr * 64 + cc * 2; return st * 1024 + (ob ^ (((ob >> 9) & 1) << 5)); }
DI void stage_rc(int b, int& R, int& C) { const int st = b / 1024, sb = b % 1024, swz = sb ^ (((sb >> 9) & 1) << 5); R = (st >> 1) * 16 + swz / 64; C = (st & 1) * 32 + (swz % 64) / 2; }
DI int perm32(int rho) { const int n = rho >> 4, i = rho & 15; return 8 * (i >> 2) + 4 * n + (i & 3); }
struct Unit { int pm, pn; };
struct Gemm { const bf16_t* A; const bf16_t* Bt; int M, N, K; };
struct StaticOrder {
    int nM, nN, nwg, G, c;
    DI void init(int M, int N, int G_, int c_) { nM = M / BM; nN = N / BM; nwg = nM * nN; G = G_; c = c_; }
    DI bool next(int i, Unit& u) const {
        const long L = (long)i * G + c; if (L >= nwg) return false;
        int wgid = (int)L; { const int q = nwg / NXCD, r = nwg % NXCD, xcd = wgid % NXCD, off = wgid / NXCD; wgid = (xcd < r ? xcd * (q + 1) : r * (q + 1) + (xcd - r) * q) + off; }
        const int nig = WGM * nN, gid = wgid / nig, fm = gid * WGM, gsz = (nM - fm) < WGM ? (nM - fm) : WGM;
        u.pm = fm + ((wgid % nig) % gsz); u.pn = (wgid % nig) / gsz; return true;
    }
};
DI unsigned cvt_pk_bf16(float lo, float hi) { return pk2(lo, hi); }

template <class Epi, bool ALIGN_EPI = true, bool SP2 = true>
DI void gemm_phase(LAS unsigned char* lds, const Gemm g, const StaticOrder& S, const Epi& E) {
    int tid = threadIdx.x; asm volatile("" : "+v"(tid));
    const int wid = __builtin_amdgcn_readfirstlane(tid >> 6), lane = tid & 63, wr = wid >> 2, wc = wid & 3, fr = lane & 15, fq = lane >> 4;
    const int K = g.K, nt = K / BK;
    unsigned voffA[2], voffB[2];
#pragma unroll
    for (int i = 0; i < 2; ++i) { int R, C; stage_rc(tid * 16 + i * 8192, R, C); const int Rb = (R & ~31) + perm32(R & 31);
        voffA[i] = (unsigned)(R * K + C) * 2u; voffB[i] = (unsigned)(Rb * K + C) * 2u; }
    const size_t kstep = (size_t)(BK * 2);
    const size_t hstep = (size_t)HALF * K * 2;
    const size_t tstep = 2 * hstep;
    const unsigned ldsw = (unsigned)wid * 1024u;
    const int aoff = lds_byte(wr * 64 + fr, fq * 8), boff = lds_byte(wc * 32 + fr, fq * 8);
#define PG8_SA(b, h) (((b) * 2 + (h)) * HTB)
#define PG8_SB(b, h) ((4 + (b) * 2 + (h)) * HTB)
#define PG8_STAGE(bufoff, gbase, voff) do { _Pragma("unroll") for (int _i = 0; _i < 2; ++_i) \
        __builtin_amdgcn_global_load_lds((const unsigned*)((const char*)(gbase) + (voff)[_i]), (LAS unsigned*)(lds + (bufoff) + ldsw + _i * 8192), 16, 0, 0); } while (0)
#define PG8_LDA(dst, b, h) do { _Pragma("unroll") for (int m = 0; m < 4; ++m) _Pragma("unroll") for (int k = 0; k < 2; ++k) dst[m][k] = *(const LAS bf16x8*)(lds + PG8_SA(b, h) + aoff + m * 2048 + k * 1024); } while (0)
#define PG8_LDB(dst, b, h) do { _Pragma("unroll") for (int n = 0; n < 2; ++n) _Pragma("unroll") for (int k = 0; k < 2; ++k) dst[n][k] = *(const LAS bf16x8*)(lds + PG8_SB(b, h) + boff + n * 2048 + k * 1024); } while (0)
#define PG8_MMA(ai, bj, At, Bt) do { __builtin_amdgcn_s_setprio(1); _Pragma("unroll") for (int m = 0; m < 4; ++m) _Pragma("unroll") for (int n = 0; n < 2; ++n) _Pragma("unroll") for (int k = 0; k < 2; ++k) \
        acc[ai][bj][m][n] = __builtin_amdgcn_mfma_f32_16x16x32_bf16(Bt[n][k], At[m][k], acc[ai][bj][m][n], 0, 0, 0); __builtin_amdgcn_s_setprio(0); } while (0)
#define PG8_WAIT_V(n) asm volatile("s_waitcnt vmcnt(" #n ")" ::: "memory")
#define PG8_WAIT_L(n) asm volatile("s_waitcnt lgkmcnt(" #n ")" ::: "memory")
#define PG8_BAR __builtin_amdgcn_s_barrier()
#define PG8_SCHED __builtin_amdgcn_sched_barrier(0)
    Unit cur, nxt; int ui = 0;
    if (!S.next(0, cur)) return;
    f32x4 acc[2][2][4][2];
#pragma unroll
    for (int a = 0; a < 2; ++a)
#pragma unroll
        for (int b = 0; b < 2; ++b)
#pragma unroll
            for (int m = 0; m < 4; ++m)
#pragma unroll
                for (int n = 0; n < 2; ++n) acc[a][b][m][n] = (f32x4){0.f, 0.f, 0.f, 0.f};
    bf16x8 At[4][2], B0[2][2], B1[2][2];
    const char* cA = (const char*)g.A + (size_t)cur.pm * tstep; const char* cB = (const char*)g.Bt + (size_t)cur.pn * tstep;
    if constexpr (SP2) {
        PG8_STAGE(PG8_SB(0, 0), cB, voffB); PG8_STAGE(PG8_SB(0, 1), cB + hstep, voffB); PG8_STAGE(PG8_SA(0, 0), cA, voffA); PG8_STAGE(PG8_SA(0, 1), cA + hstep, voffA);
        if (wr == 1) PG8_BAR;
        PG8_WAIT_V(2); PG8_BAR;
        PG8_STAGE(PG8_SB(1, 0), cB + kstep, voffB); PG8_STAGE(PG8_SA(1, 0), cA + kstep, voffA); PG8_STAGE(PG8_SB(1, 1), cB + hstep + kstep, voffB);
        PG8_WAIT_V(6); PG8_BAR;
    } else {
        PG8_STAGE(PG8_SB(0, 0), cB, voffB); PG8_STAGE(PG8_SA(0, 0), cA, voffA); PG8_STAGE(PG8_SB(0, 1), cB + hstep, voffB); PG8_STAGE(PG8_SA(0, 1), cA + hstep, voffA);
        if (wr == 1) PG8_BAR;
        PG8_WAIT_V(4); PG8_BAR;
        PG8_STAGE(PG8_SB(1, 0), cB + kstep, voffB); PG8_STAGE(PG8_SA(1, 0), cA + kstep, voffA); PG8_STAGE(PG8_SB(1, 1), cB + hstep + kstep, voffB);
        PG8_WAIT_V(6); PG8_BAR;
    }
    for (;;) {
        const bool has_next = S.next(ui + 1, nxt);
        const char* nA = has_next ? (const char*)g.A + (size_t)nxt.pm * tstep : cA; const char* nB = has_next ? (const char*)g.Bt + (size_t)nxt.pn * tstep : cB;
        for (int t = 0; t < nt; t += 2) {
            const bool last = (t == nt - 2);
            const char* a1 = cA + (size_t)(t + 1) * kstep;
            const char* a2 = last ? nA : cA + (size_t)(t + 2) * kstep; const char* b2 = last ? nB : cB + (size_t)(t + 2) * kstep;
            const char* a3 = a2 + kstep; const char* b3 = b2 + kstep;
            if constexpr (SP2) {
            PG8_LDB(B0, 0, 0); PG8_LDB(B1, 0, 1); PG8_SCHED; PG8_LDA(At, 0, 0); PG8_STAGE(PG8_SA(1, 1), a1 + hstep, voffA);
            PG8_WAIT_V(8); PG8_WAIT_L(0); PG8_BAR; PG8_MMA(0, 0, At, B0); PG8_MMA(0, 1, At, B1); PG8_BAR; PG8_SCHED;
            PG8_LDA(At, 0, 1); PG8_STAGE(PG8_SB(0, 0), b2, voffB); PG8_STAGE(PG8_SB(0, 1), b2 + hstep, voffB); PG8_STAGE(PG8_SA(0, 0), a2, voffA);
            PG8_WAIT_V(8); PG8_WAIT_L(0); PG8_BAR; PG8_MMA(1, 0, At, B0); PG8_MMA(1, 1, At, B1); PG8_BAR; PG8_SCHED;
            PG8_LDB(B0, 1, 0); PG8_LDB(B1, 1, 1); PG8_SCHED; PG8_LDA(At, 1, 0); PG8_STAGE(PG8_SA(0, 1), a2 + hstep, voffA);
            PG8_WAIT_V(8); PG8_WAIT_L(0); PG8_BAR; PG8_MMA(0, 0, At, B0); PG8_MMA(0, 1, At, B1); PG8_BAR; PG8_SCHED;
            PG8_LDA(At, 1, 1); PG8_STAGE(PG8_SB(1, 0), b3, voffB); PG8_STAGE(PG8_SB(1, 1), b3 + hstep, voffB); PG8_STAGE(PG8_SA(1, 0), a3, voffA);
            PG8_WAIT_V(8); PG8_WAIT_L(0); PG8_BAR; PG8_MMA(1, 0, At, B0); PG8_MMA(1, 1, At, B1); PG8_BAR; PG8_SCHED;
            } else {
            PG8_LDB(B0, 0, 0); PG8_SCHED; PG8_LDA(At, 0, 0); PG8_STAGE(PG8_SA(1, 1), a1 + hstep, voffA);
            PG8_WAIT_L(8); PG8_BAR; PG8_WAIT_L(0); PG8_MMA(0, 0, At, B0); PG8_BAR; PG8_SCHED;
            PG8_LDB(B1, 0, 1); PG8_STAGE(PG8_SB(0, 0), b2, voffB);
            PG8_BAR; PG8_WAIT_L(0); PG8_MMA(0, 1, At, B1); PG8_BAR;
            PG8_LDA(At, 0, 1); PG8_STAGE(PG8_SA(0, 0), a2, voffA);
            PG8_BAR; PG8_WAIT_L(0); PG8_MMA(1, 0, At, B0); PG8_BAR; PG8_SCHED;
            PG8_STAGE(PG8_SB(0, 1), b2 + hstep, voffB);
            PG8_WAIT_V(6); PG8_BAR; PG8_MMA(1, 1, At, B1); PG8_BAR;
            PG8_LDB(B0, 1, 0); PG8_SCHED; PG8_LDA(At, 1, 0); PG8_STAGE(PG8_SA(0, 1), a2 + hstep, voffA);
            PG8_WAIT_L(8); PG8_BAR; PG8_WAIT_L(0); PG8_MMA(0, 0, At, B0); PG8_BAR; PG8_SCHED;
            PG8_LDB(B1, 1, 1); PG8_STAGE(PG8_SB(1, 0), b3, voffB);
            PG8_BAR; PG8_WAIT_L(0); PG8_MMA(0, 1, At, B1); PG8_BAR;
            PG8_LDA(At, 1, 1); PG8_STAGE(PG8_SA(1, 0), a3, voffA);
            PG8_BAR; PG8_WAIT_L(0); PG8_MMA(1, 0, At, B0); PG8_BAR; PG8_SCHED;
            PG8_STAGE(PG8_SB(1, 1), b3 + hstep, voffB);
            PG8_WAIT_V(6); PG8_BAR; PG8_MMA(1, 1, At, B1); PG8_BAR;
            }
        }
        if constexpr (ALIGN_EPI) { if (wr == 0) PG8_BAR; }
        E(acc, cur, wr, wc, fr, fq);
        if (!has_next) break;
#pragma unroll
        for (int a = 0; a < 2; ++a)
#pragma unroll
            for (int b = 0; b < 2; ++b)
#pragma unroll
                for (int m = 0; m < 4; ++m)
#pragma unroll
                    for (int n = 0; n < 2; ++n) acc[a][b][m][n] = (f32x4){0.f, 0.f, 0.f, 0.f};
        cur = nxt; cA = nA; cB = nB; ++ui;
        if constexpr (ALIGN_EPI) { if (wr == 1) PG8_BAR; }
    }
    PG8_WAIT_V(0);
    if constexpr (!ALIGN_EPI) { if (wr == 0) PG8_BAR; }
    PG8_BAR;
#undef PG8_SA
#undef PG8_SB
#undef PG8_STAGE
#undef PG8_LDA
#undef PG8_LDB
#undef PG8_MMA
#undef PG8_WAIT_V
#undef PG8_WAIT_L
#undef PG8_BAR
#undef PG8_SCHED
}

typedef f32x4 Acc[2][2][4][2];

DI void row_scales(const float* ssp, int row0, int fq, float (&rs)[2][4]) {
#pragma unroll
    for (int ai = 0; ai < 2; ++ai)
#pragma unroll
        for (int m = 0; m < 4; ++m) {
            const f32x4 p = *(const f32x4*)(ssp + (size_t)(row0 + ai * HALF + m * 16) * 16 + 4 * fq);
            float s = (p.x + p.y) + (p.z + p.w); s += __shfl_xor(s, 16); s += __shfl_xor(s, 32);
            rs[ai][m] = rsqrtf(s * (1.0f / 1024.0f) + EPS);
        }
}

DI float row_scale1(const float* ssp, int row, int fq) {
    const f32x4 p = *(const f32x4*)(ssp + (size_t)row * 16 + 4 * fq);
    float s = (p.x + p.y) + (p.z + p.w); s += __shfl_xor(s, 16); s += __shfl_xor(s, 32);
    return rsqrtf(s * (1.0f / 1024.0f) + EPS);
}
template <int ACT> DI void store_plain(Acc& acc, const float* ssp, bf16_t* O, int ldc, int row0, int col0, int fq) {
    float rs[2][4]; row_scales(ssp, row0, fq, rs);
#pragma unroll
    for (int ai = 0; ai < 2; ++ai)
#pragma unroll
        for (int m = 0; m < 4; ++m) { int r0v = row0; asm volatile("" : "+v"(r0v)); const int row = r0v + ai * HALF + m * 16; bf16_t* rowp = O + (size_t)row * ldc + col0; const float s = rs[ai][m];
#pragma unroll
            for (int bj = 0; bj < 2; ++bj) { f32x4 v0 = acc[ai][bj][m][0] * s, v1 = acc[ai][bj][m][1] * s;
                if (ACT == 1) {
#pragma unroll
                    for (int j = 0; j < 4; ++j) { v0[j] = gelu_tanh(v0[j]); v1[j] = gelu_tanh(v1[j]); } }
                if (ACT == 2) {
#pragma unroll
                    for (int j = 0; j < 4; ++j) { v0[j] = sigmoidf_(v0[j]); v1[j] = sigmoidf_(v1[j]); } }
                u32x4 w; w.x = cvt_pk_bf16(v0[0], v0[1]); w.y = cvt_pk_bf16(v0[2], v0[3]); w.z = cvt_pk_bf16(v1[0], v1[1]); w.w = cvt_pk_bf16(v1[2], v1[3]);
                *(u32x4*)(rowp + bj * HALF) = w; } }
}
struct EpiIn {
    const float* ssp; bf16_t *XR, *GG, *SGR, *SGA, *Q, *Kc, *V; const float *qg, *kg, *cosT, *sinT; LAS float* tab;
    DI void operator()(Acc& acc, const Unit& u, int wr, int wc, int fr, int fq) const {
        const int row0 = u.pm * BM + wr * 64 + fr, pn = u.pn;
        if (pn < 16 || pn >= 28) {
            const int cw = wc * 32 + 8 * fq;
            if (pn < 4) store_plain<0>(acc, ssp, XR, 1024, row0, pn * 256 + cw, fq);
            else if (pn < 8) store_plain<1>(acc, ssp, GG, 1024, row0, (pn - 4) * 256 + cw, fq);
            else if (pn < 12) store_plain<2>(acc, ssp, SGR, 1024, row0, (pn - 8) * 256 + cw, fq);
            else if (pn < 16) store_plain<2>(acc, ssp, SGA, 1024, row0, (pn - 12) * 256 + cw, fq);
            else store_plain<0>(acc, ssp, V, 1536, row0, (pn - 28) * 256 + cw, fq);
        } else {
            const bool isq = pn < 22; const int head0 = 2 * (pn - (isq ? 16 : 22)); bf16_t* O = isq ? Q : Kc; const float* gw = isq ? qg : kg; const float osc = isq ? 0.08838834764831845f : 1.0f;
            const int d0 = 16 * wc + 4 * fq;
            float rs[2][4]; row_scales(ssp, row0, fq, rs);
#pragma unroll
            for (int ai = 0; ai < 2; ++ai)
#pragma unroll
                for (int m = 0; m < 4; ++m) { int r0v = row0; asm volatile("" : "+v"(r0v)); const float s = rs[ai][m]; const int rl = (r0v & 255) + ai * HALF + m * 16;
#pragma unroll
                    for (int bj = 0; bj < 2; ++bj) { const f32x4 a = acc[ai][bj][m][0], b = acc[ai][bj][m][1];
                        float q = (a[0] * a[0] + a[1] * a[1]) + (a[2] * a[2] + a[3] * a[3]) + (b[0] * b[0] + b[1] * b[1]) + (b[2] * b[2] + b[3] * b[3]);
                        q *= s * s; q += __shfl_xor(q, 16); q += __shfl_xor(q, 32);
                        if (fq == 0) tab[(rl * 2 + bj) * 4 + wc] = q; } }
            asm volatile("s_waitcnt lgkmcnt(0)" ::: "memory"); __builtin_amdgcn_s_barrier(); asm volatile("" ::: "memory");
            const f32x4 g1a = *(const f32x4*)(gw + head0 * 128 + d0), g2a = *(const f32x4*)(gw + head0 * 128 + 64 + d0);
            const f32x4 g1b = *(const f32x4*)(gw + head0 * 128 + 128 + d0), g2b = *(const f32x4*)(gw + head0 * 128 + 192 + d0);
#pragma unroll
            for (int ai = 0; ai < 2; ++ai)
#pragma unroll
                for (int m = 0; m < 4; ++m) { int r0v = row0; asm volatile("" : "+v"(r0v)); const int rl = (r0v & 255) + ai * HALF + m * 16; const size_t row = (size_t)(r0v + ai * HALF + m * 16);
                    const f32x4 cs = *(const f32x4*)(cosT + row * 64 + d0), sn = *(const f32x4*)(sinT + row * 64 + d0); const float s = rs[ai][m] * osc;
#pragma unroll
                    for (int bj = 0; bj < 2; ++bj) { const f32x4 pp = *(const LAS f32x4*)(tab + (rl * 2 + bj) * 4);
                        const float inv = rsqrtf(((pp.x + pp.y) + (pp.z + pp.w)) * (1.0f / 128.0f) + EPS) * s;
                        const f32x4 x1 = acc[ai][bj][m][0] * inv * (bj ? g1b : g1a), x2 = acc[ai][bj][m][1] * inv * (bj ? g2b : g2a);
                        const f32x4 o1 = x1 * cs - x2 * sn, o2 = x2 * cs + x1 * sn;
                        u32x2 w1, w2; w1.x = cvt_pk_bf16(o1[0], o1[1]); w1.y = cvt_pk_bf16(o1[2], o1[3]); w2.x = cvt_pk_bf16(o2[0], o2[1]); w2.y = cvt_pk_bf16(o2[2], o2[3]);
                        bf16_t* p = O + row * AW + (head0 + bj) * 128 + d0; *(u32x2*)p = w1; *(u32x2*)(p + 64) = w2; }
                    if (m & 1) asm volatile("" ::: "memory"); }
        }
    }
};
struct EpiProj1 {
    const bf16_t* SG; bf16_t* TMP;
    DI void operator()(Acc& acc, const Unit& u, int wr, int wc, int fr, int fq) const {
        const int row0 = u.pm * BM + wr * 64 + fr, col0 = u.pn * BM + wc * 32 + 8 * fq;
#pragma unroll
        for (int ai = 0; ai < 2; ++ai)
#pragma unroll
            for (int m = 0; m < 4; ++m) { int r0v = row0; asm volatile("" : "+v"(r0v)); const size_t off = (size_t)(r0v + ai * HALF + m * 16) * DM + col0;
#pragma unroll
                for (int bj = 0; bj < 2; ++bj) { const u32x4 sg = *(const u32x4*)(SG + off + bj * HALF);
                    f32x4 v0 = acc[ai][bj][m][0], v1 = acc[ai][bj][m][1];
                    v0[0] *= bflo(sg.x); v0[1] *= bfhi(sg.x); v0[2] *= bflo(sg.y); v0[3] *= bfhi(sg.y); v1[0] *= bflo(sg.z); v1[1] *= bfhi(sg.z); v1[2] *= bflo(sg.w); v1[3] *= bfhi(sg.w);
                    u32x4 w; w.x = cvt_pk_bf16(v0[0], v0[1]); w.y = cvt_pk_bf16(v0[2], v0[3]); w.z = cvt_pk_bf16(v1[0], v1[1]); w.w = cvt_pk_bf16(v1[2], v1[3]);
                    *(u32x4*)(TMP + off + bj * HALF) = w; }
                if (m & 1) asm volatile("" ::: "memory"); }
    }
};
struct EpiProj2 {
    const bf16_t* SG; const bf16_t* TMP; bf16_t* MG;
    DI void operator()(Acc& acc, const Unit& u, int wr, int wc, int fr, int fq) const {
        const int row0 = u.pm * BM + wr * 64 + fr, col0 = u.pn * BM + wc * 32 + 8 * fq;
#pragma unroll
        for (int ai = 0; ai < 2; ++ai)
#pragma unroll
            for (int m = 0; m < 4; ++m) { int r0v = row0; asm volatile("" : "+v"(r0v)); const size_t off = (size_t)(r0v + ai * HALF + m * 16) * DM + col0;
#pragma unroll
                for (int bj = 0; bj < 2; ++bj) { const u32x4 sg = *(const u32x4*)(SG + off + bj * HALF); const u32x4 tm = *(const u32x4*)(TMP + off + bj * HALF);
                    f32x4 v0 = acc[ai][bj][m][0], v1 = acc[ai][bj][m][1];
                    v0[0] = bflo(tm.x) + v0[0] * bflo(sg.x); v0[1] = bfhi(tm.x) + v0[1] * bfhi(sg.x); v0[2] = bflo(tm.y) + v0[2] * bflo(sg.y); v0[3] = bfhi(tm.y) + v0[3] * bfhi(sg.y);
                    v1[0] = bflo(tm.z) + v1[0] * bflo(sg.z); v1[1] = bfhi(tm.z) + v1[1] * bfhi(sg.z); v1[2] = bflo(tm.w) + v1[2] * bflo(sg.w); v1[3] = bfhi(tm.w) + v1[3] * bfhi(sg.w);
                    u32x4 w; w.x = cvt_pk_bf16(v0[0], v0[1]); w.y = cvt_pk_bf16(v0[2], v0[3]); w.z = cvt_pk_bf16(v1[0], v1[1]); w.w = cvt_pk_bf16(v1[2], v1[3]);
                    *(u32x4*)(MG + off + bj * HALF) = w; }
                if (m & 1) asm volatile("" ::: "memory"); }
    }
};
struct EpiResid {
    float* xout; bf16_t* XB; float* ssp; int final_;
    DI void operator()(Acc& acc, const Unit& u, int wr, int wc, int fr, int fq) const {
        const int row0 = u.pm * BM + wr * 64 + fr, col0 = u.pn * BM + wc * 32 + 8 * fq;
#pragma unroll
        for (int ai = 0; ai < 2; ++ai)
#pragma unroll
            for (int m = 0; m < 4; ++m) { int r0v = row0; asm volatile("" : "+v"(r0v)); const int row = r0v + ai * HALF + m * 16; const size_t off = (size_t)row * DM + col0; float q = 0.f;
#pragma unroll
                for (int bj = 0; bj < 2; ++bj) {
                    const u32x4 xo = *(const u32x4*)(XB + off + bj * HALF);
                    f32x4 o0 = acc[ai][bj][m][0], o1 = acc[ai][bj][m][1];
                    o0[0] += bflo(xo.x); o0[1] += bfhi(xo.x); o0[2] += bflo(xo.y); o0[3] += bfhi(xo.y); o1[0] += bflo(xo.z); o1[1] += bfhi(xo.z); o1[2] += bflo(xo.w); o1[3] += bfhi(xo.w);
                    q += (o0[0] * o0[0] + o0[1] * o0[1]) + (o0[2] * o0[2] + o0[3] * o0[3]) + (o1[0] * o1[0] + o1[1] * o1[1]) + (o1[2] * o1[2] + o1[3] * o1[3]);
                    if (final_) { *(f32x4*)(xout + off + bj * HALF) = o0; *(f32x4*)(xout + off + bj * HALF + 4) = o1; }
                    else { u32x4 w; w.x = cvt_pk_bf16(o0[0], o0[1]); w.y = cvt_pk_bf16(o0[2], o0[3]); w.z = cvt_pk_bf16(o1[0], o1[1]); w.w = cvt_pk_bf16(o1[2], o1[3]);
                        *(u32x4*)(XB + off + bj * HALF) = w; } }
                q += __shfl_xor(q, 16); q += __shfl_xor(q, 32);
                if (fq == 0) ssp[(size_t)row * 16 + u.pn * 4 + wc] = q;
                if (m & 1) asm volatile("" ::: "memory"); }
    }
};
struct EpiUp {
    const float* ssp; bf16_t* U;
    DI void operator()(Acc& acc, const Unit& u, int wr, int wc, int fr, int fq) const {
        const int row0 = u.pm * BM + wr * 64 + fr, col0 = u.pn * BM + wc * 32 + 8 * fq;
        float rs[2][4]; row_scales(ssp, row0, fq, rs);
#pragma unroll
        for (int ai = 0; ai < 2; ++ai)
#pragma unroll
            for (int m = 0; m < 4; ++m) { int r0v = row0; asm volatile("" : "+v"(r0v)); const int row = r0v + ai * HALF + m * 16; bf16_t* rowp = U + (size_t)row * NUP + col0; const float s = rs[ai][m];
#pragma unroll
                for (int bj = 0; bj < 2; ++bj) { const f32x4 v0 = acc[ai][bj][m][0] * s, v1 = acc[ai][bj][m][1] * s;
                    u32x4 w; w.x = cvt_pk_bf16(v0[0], v0[1]); w.y = cvt_pk_bf16(v0[2], v0[3]); w.z = cvt_pk_bf16(v1[0], v1[1]); w.w = cvt_pk_bf16(v1[2], v1[3]);
                    *(u32x4*)(rowp + bj * HALF) = w; } }
    }
};
}

#define XB_TMO      128
#define XB_XCNT(j)  (256  + 64 * (j))
#define XB_XSUB(j)  (1280 + 64 * (j))
#define XB_XGEN(j)  (2304 + 64 * (j))
#define XB_TOP      3328
#define XB_TOPGEN   3392
#define XB_SPIN_CAP (1u << 22)
DI unsigned xb_ld(unsigned* p)              { return __hip_atomic_load(p, __ATOMIC_RELAXED, __HIP_MEMORY_SCOPE_AGENT); }
DI unsigned xb_add(unsigned* p, unsigned v) { return __hip_atomic_fetch_add(p, v, __ATOMIC_RELAXED, __HIP_MEMORY_SCOPE_AGENT); }
DI unsigned xb_xcc_id() { return (unsigned)__builtin_amdgcn_s_getreg((3 << 11) | 20) & 0xFu; }
#define XB_SPIN(cond, bar) do { unsigned _sp = 0; while (cond) { __builtin_amdgcn_s_sleep(1); \
    if ((++_sp & 255u) == 0u) { if (xb_ld(&(bar)[XB_TMO])) break; if (_sp > XB_SPIN_CAP) { atomicAdd(&(bar)[XB_TMO], 1u); break; } } } } while (0)
struct XcdBarrier { unsigned* bar; unsigned x; volatile LAS unsigned* st; };
DI XcdBarrier xcd_barrier_post(unsigned* bar, volatile LAS unsigned* st) {
    XcdBarrier b; b.bar = bar; b.x = xb_xcc_id(); b.st = st;
    if (threadIdx.x == 0) (void)xb_add(&bar[XB_XCNT(b.x)], 1u);
    return b;
}
DI void xcd_barrier_complete(unsigned* bar, unsigned x, unsigned& nloc, unsigned& nx) {
    const unsigned G = gridDim.x * gridDim.y * gridDim.z;
    unsigned sum, cnt, mine, sp = 0u;
    for (;;) {
        sum = 0u; cnt = 0u; mine = 0u;
#pragma unroll
        for (unsigned j = 0; j < 16; ++j) { const unsigned c = xb_ld(&bar[XB_XCNT(j)]); sum += c; cnt += (c > 0u) ? 1u : 0u; mine = (j == x) ? c : mine; }
        if (sum == G) break;
        __builtin_amdgcn_s_sleep(1);
        if ((++sp & 255u) == 0u) { if (xb_ld(&bar[XB_TMO])) break; if (sp > XB_SPIN_CAP) { atomicAdd(&bar[XB_TMO], 1u); break; } }
    }
    nloc = mine > 0u ? mine : 1u; nx = cnt > 0u ? cnt : 1u;
}
DI void xcd_barrier(const XcdBarrier& b) {
    asm volatile("s_waitcnt vmcnt(0)" ::: "memory");
    __syncthreads();
    if (threadIdx.x == 0) {
        unsigned* bar = b.bar;
        __builtin_amdgcn_s_waitcnt(0);
        unsigned nloc = b.st[0], nx = b.st[1];
        if (nloc == 0u) { xcd_barrier_complete(bar, b.x, nloc, nx); b.st[0] = nloc; b.st[1] = nx; }
        const unsigned old = xb_add(&bar[XB_XSUB(b.x)], 1u);
        const unsigned gen = old / nloc;
        if (old + 1u == (gen + 1u) * nloc) {
            __builtin_amdgcn_fence(__ATOMIC_RELEASE, "agent");
            asm volatile("s_waitcnt vmcnt(0)" ::: "memory");
            const unsigned og = xb_add(&bar[XB_TOP], 1u);
            const unsigned tg = og / nx;
            if (og + 1u == (tg + 1u) * nx) xb_add(&bar[XB_TOPGEN], 1u);
            else XB_SPIN(xb_ld(&bar[XB_TOPGEN]) == tg, bar);
            __builtin_amdgcn_fence(__ATOMIC_ACQUIRE, "agent");
            xb_add(&bar[XB_XGEN(b.x)], 1u);
            asm volatile("s_waitcnt vmcnt(0)" ::: "memory");
        } else {
            XB_SPIN(xb_ld(&bar[XB_XGEN(b.x)]) == gen, bar);
            __builtin_amdgcn_fence(__ATOMIC_ACQUIRE, "agent");
            asm volatile("s_waitcnt vmcnt(0)" ::: "memory");
        }
    }
    __syncthreads();
}

struct Args { const void* in[21]; float* out; unsigned char* ws; int ph_lo, ph_hi, coop, pad; };
typedef const Args __attribute__((address_space(4)))* CArgsP;
#define GAS1 __attribute__((address_space(1)))
DI const float* inF(CArgsP a, int k) { return (const float*)(GAS1 const float*)a->in[k]; }
DI const int* inI(CArgsP a, int k) { return (const int*)(GAS1 const int*)a->in[k]; }
DI float* outF(CArgsP a) { return (float*)(GAS1 float*)a->out; }
DI unsigned char* wsG(CArgsP a) { return (unsigned char*)(GAS1 unsigned char*)a->ws; }

DI int qkperm(int d) { return 32 * ((d >> 4) & 3) + 8 * ((d >> 2) & 3) + 4 * (d >> 6) + (d & 3); }
DI int map_in(int n) {
    if (n < 2048) return n;
    if (n < 3584) { const int e = n - 2048; return 4096 + (e & ~127) + qkperm(e & 127); }
    if (n < 5120) { const int e = n - 3584; return 5632 + (e & ~127) + qkperm(e & 127); }
    if (n < 6656) return 7168 + (n - 5120);
    return 2048 + (n - 6656);
}
DI void transpose_item(const float* W, int K, int N, bf16_t* WT, const float* gk, int mapkind, LAS float* scr, int item, int lane) {
    const int nblk = N / 32, kb = item / nblk, nb = item % nblk, k0 = 64 * kb, n0 = 32 * nb;
    float wv[32];
    const float* wp = W + (size_t)(k0 + (lane >> 5)) * N + n0 + (lane & 31);
#pragma unroll
    for (int i = 0; i < 32; ++i) wv[i] = __builtin_nontemporal_load(wp + (size_t)(2 * i) * N);
    if (gk) {
        const float* gp = gk + k0 + (lane >> 5);
#pragma unroll
        for (int i = 0; i < 32; ++i) wv[i] *= gp[2 * i]; }
#pragma unroll
    for (int i = 0; i < 32; ++i) scr[(2 * i + (lane >> 5)) * 33 + (lane & 31)] = wv[i];
    LDS_WAIT(); asm volatile("" ::: "memory");
    const int c = lane & 7;
#pragma unroll
    for (int j = 0; j < 4; ++j) { const int n = (lane >> 3) + 8 * j; const LAS float* s = scr + (8 * c) * 33 + n;
        u32x4 o; o.x = pk2(s[0 * 33], s[1 * 33]); o.y = pk2(s[2 * 33], s[3 * 33]); o.z = pk2(s[4 * 33], s[5 * 33]); o.w = pk2(s[6 * 33], s[7 * 33]);
        const int dst = mapkind ? map_in(n0 + n) : (n0 + n);
        *(u32x4*)(WT + (size_t)dst * K + k0 + 8 * c) = o; }
    LDS_WAIT(); asm volatile("" ::: "memory");
}
DI void convert_weights(CArgsP a, int l, int mask, LAS unsigned char* lds, int gw, int NGW, int wave, int lane) {
    LAS float* scr = (LAS float*)(lds + wave * 8448);
    unsigned char* ws = wsG(a);
    constexpr int I_IN = 16 * 272, I_LRU = 8 * 8, I_DN = 48 * 32, I_PR = 16 * 32, I_PA = 8 * 32, I_WO = 16 * 32, I_UP = 16 * 192;
    const int total = ((mask & 1) ? I_IN : 0) + ((mask & 2) ? 2 * I_LRU : 0) + ((mask & 4) ? I_DN : 0) + ((mask & 8) ? (I_PR + I_PA + I_WO + I_UP) : 0);
    for (int it = gw; it < total; it += NGW) {
        int r = it;
        if (mask & 1) { if (r < I_IN) { transpose_item(inF(a, 3) + (size_t)l * DM * NIN, DM, NIN, (bf16_t*)(ws + WS_W1T), inF(a, 2) + l * DM, 1, scr, r, lane); continue; } r -= I_IN; }
        if (mask & 2) {
            if (r < I_LRU) { const int blk = r >> 3; transpose_item(inF(a, 6) + (size_t)l * 131072 + blk * 16384, 128, 128, (bf16_t*)(ws + WS_WAT) + blk * 16384, nullptr, 0, scr, r & 7, lane); continue; } r -= I_LRU;
            if (r < I_LRU) { const int blk = r >> 3; transpose_item(inF(a, 8) + (size_t)l * 131072 + blk * 16384, 128, 128, (bf16_t*)(ws + WS_WXT) + blk * 16384, nullptr, 0, scr, r & 7, lane); continue; } r -= I_LRU; }
        if (mask & 4) { if (r < I_DN) { transpose_item(inF(a, 20) + (size_t)l * DFF * DM, DFF, DM, (bf16_t*)(ws + WS_WDT), nullptr, 0, scr, r, lane); continue; } r -= I_DN; }
        if (mask & 8) {
            if (r < I_PR) { transpose_item(inF(a, 13) + (size_t)l * DM * DM, DM, DM, (bf16_t*)(ws + WS_PRT), nullptr, 0, scr, r, lane); continue; } r -= I_PR;
            if (r < I_PA) { transpose_item(inF(a, 14) + (size_t)l * 512 * DM, 512, DM, (bf16_t*)(ws + WS_PAT), nullptr, 0, scr, r, lane); continue; } r -= I_PA;
            if (r < I_WO) { transpose_item(inF(a, 15) + (size_t)l * DM * DM, DM, DM, (bf16_t*)(ws + WS_WOT), nullptr, 0, scr, r, lane); continue; } r -= I_WO;
            transpose_item(inF(a, 17) + (size_t)l * DM * NUP, DM, NUP, (bf16_t*)(ws + WS_WUT), inF(a, 16) + l * DM, 0, scr, r, lane); }
    }
}

DI void p0_rows(CArgsP a, int gw, int NGW, int lane) {
    const float* x = inF(a, 0); bf16_t* XB = (bf16_t*)(wsG(a) + WS_XB); float* ssp = (float*)(wsG(a) + WS_SSP);
    for (int m0 = 2 * gw; m0 < T; m0 += 2 * NGW) {
        const f32x4* xr0 = (const f32x4*)(x + (size_t)m0 * DM) + lane; const f32x4* xr1 = xr0 + DM / 4; f32x4 v[2][4]; float s0 = 0.f, s1 = 0.f;
#pragma unroll
        for (int j = 0; j < 4; ++j) { v[0][j] = __builtin_nontemporal_load(xr0 + 64 * j); v[1][j] = __builtin_nontemporal_load(xr1 + 64 * j); }
#pragma unroll
        for (int j = 0; j < 4; ++j) { s0 += (v[0][j].x * v[0][j].x + v[0][j].y * v[0][j].y) + (v[0][j].z * v[0][j].z + v[0][j].w * v[0][j].w);
                                      s1 += (v[1][j].x * v[1][j].x + v[1][j].y * v[1][j].y) + (v[1][j].z * v[1][j].z + v[1][j].w * v[1][j].w); }
#pragma unroll
        for (int o = 1; o < 64; o <<= 1) { s0 += __shfl_xor(s0, o); s1 += __shfl_xor(s1, o); }
        u32x2* o0 = (u32x2*)(XB + (size_t)m0 * DM) + lane; u32x2* o1 = o0 + DM / 4;
#pragma unroll
        for (int j = 0; j < 4; ++j) { u32x2 w; w.x = pk2(v[0][j].x, v[0][j].y); w.y = pk2(v[0][j].z, v[0][j].w); o0[64 * j] = w;
                                      u32x2 w1; w1.x = pk2(v[1][j].x, v[1][j].y); w1.y = pk2(v[1][j].z, v[1][j].w); o1[64 * j] = w1; }
        if (lane < 16) ssp[(size_t)m0 * 16 + lane] = (lane == 0) ? s0 : 0.f;
        else if (lane < 32) ssp[(size_t)(m0 + 1) * 16 + (lane - 16)] = (lane == 16) ? s1 : 0.f;
    }
}
DI void p0_rope(CArgsP a, int gtid, int nthr) {
    const int* pos = inI(a, 1); float* cosT = (float*)(wsG(a) + WS_COS); float* sinT = (float*)(wsG(a) + WS_SIN);
    for (int i = gtid; i < T * 64; i += nthr) {
        const int t = i >> 6, f = i & 63;
        const float inv = exp2f(-(float)f * (13.287712379549449f / 64.0f));
        const float ang = (float)pos[t] * inv;
        const double ad = (double)ang; const double kk = __builtin_rint(ad * 0.15915494309189535); const float r = (float)(ad - kk * 6.283185307179586);
        cosT[i] = __cosf(r); sinT[i] = __sinf(r);
    }
}

#define MFMA32(a, b, c) __builtin_amdgcn_mfma_f32_32x32x16_bf16((a), (b), (c), 0, 0, 0)
DI void lru_phase(CArgsP a, int l, LAS unsigned char* lds, int G, int tid, int wave, int lane) {
    unsigned char* ws = wsG(a);
    const bf16_t* XR = (const bf16_t*)(ws + WS_AR + AR_XR);
    LAS unsigned char* XCb = lds;
    LAS float* XCF = (LAS float*)(lds + 17408);
    LAS float* AA = (LAS float*)(lds + 17408 + 32768);
    const int cg8 = tid & 15, tr = tid >> 4;
    const int r = lane & 31, h = lane >> 5;
    const int cl = 16 * wave + (r & 15); const bool isI = r >= 16;
    int cur_n = -1;
    float w[4][8], bb[8]; bf16x8 bfr[8]; float bias = 0.f, sp8 = 0.f;
    unsigned long long pt0 = 0, pt1 = 0, pt2 = 0, pt3 = 0, pa0 = 0, pa1 = 0, pa2 = 0;
    u32x4 xv[2][4];
#define LRU_LOAD_XR(IT) do { const int b_ = (IT) >> 8, n_ = ((IT) >> 5) & 7, ck_ = (IT) & 31; const int c_ = n_ * 128 + 8 * cg8; \
        _Pragma("unroll") for (int j = 0; j < 2; ++j) _Pragma("unroll") for (int i = 0; i < 4; ++i) { const int p = ck_ * 64 + tr + 32 * j - 3 + i; \
            xv[j][i] = *(const u32x4*)(XR + (size_t)(b_ * SEQ + (p < 0 ? 0 : p)) * DM + c_); } } while (0)
    if ((int)blockIdx.x < 2048) LRU_LOAD_XR((int)blockIdx.x);
    for (int item = blockIdx.x; item < 2048; item += G) {
        const int b = item >> 8, n = (item >> 5) & 7, ck = item & 31;
        const int t0 = b * SEQ + ck * 64, c0 = n * 128;
        if (n != cur_n) {
            cur_n = n;
            const int c = c0 + 8 * cg8;
            const float* cw = inF(a, 4) + (size_t)l * 4 * DM + c; const float* cb = inF(a, 5) + (size_t)l * DM + c;
#pragma unroll
            for (int i = 0; i < 4; ++i) { const f32x4 w0 = *(const f32x4*)(cw + i * DM), w1 = *(const f32x4*)(cw + i * DM + 4);
#pragma unroll
                for (int e = 0; e < 4; ++e) { w[i][e] = w0[e]; w[i][4 + e] = w1[e]; } }
            { const f32x4 b0 = *(const f32x4*)cb, b1 = *(const f32x4*)(cb + 4);
#pragma unroll
              for (int e = 0; e < 4; ++e) { bb[e] = b0[e]; bb[4 + e] = b1[e]; } }
            const bf16_t* wrow = (r < 16) ? (const bf16_t*)(ws + WS_WAT) + n * 16384 + (16 * wave + r) * 128 : (const bf16_t*)(ws + WS_WXT) + n * 16384 + (16 * wave + r - 16) * 128;
#pragma unroll
            for (int ks = 0; ks < 8; ++ks) bfr[ks] = *(const bf16x8*)(wrow + 16 * ks + 8 * h);
            bias = isI ? (inF(a, 9))[(size_t)l * DM + c0 + cl] : (inF(a, 7))[(size_t)l * DM + c0 + cl];
            const float lam = (inF(a, 10))[(size_t)l * DM + c0 + cl];
            sp8 = 8.0f * log1pf(expf(-lam));
        }
        if (PROBE_SEL >= 0) pt0 = __builtin_amdgcn_s_memrealtime();
        {
#pragma unroll
            for (int j = 0; j < 2; ++j) { const int tl = tr + 32 * j, tp = ck * 64 + tl; float o[8];
#pragma unroll
                for (int e = 0; e < 8; ++e) o[e] = bb[e];
#pragma unroll
                for (int i = 0; i < 4; ++i) { const int p = tp - 3 + i; const float z = (p >= 0) ? 1.0f : 0.0f; const u32x4 v = xv[j][i];
                    o[0] += z * w[i][0] * bflo(v.x); o[1] += z * w[i][1] * bfhi(v.x); o[2] += z * w[i][2] * bflo(v.y); o[3] += z * w[i][3] * bfhi(v.y);
                    o[4] += z * w[i][4] * bflo(v.z); o[5] += z * w[i][5] * bfhi(v.z); o[6] += z * w[i][6] * bflo(v.w); o[7] += z * w[i][7] * bfhi(v.w); }
                *(LAS f32x4*)(XCF + tl * 128 + 8 * cg8) = (f32x4){o[0], o[1], o[2], o[3]}; *(LAS f32x4*)(XCF + tl * 128 + 8 * cg8 + 4) = (f32x4){o[4], o[5], o[6], o[7]};
                u32x4 pw; pw.x = pk2(o[0], o[1]); pw.y = pk2(o[2], o[3]); pw.z = pk2(o[4], o[5]); pw.w = pk2(o[6], o[7]);
                *(LAS u32x4*)(XCb + tl * 272 + 16 * cg8) = pw; }
            if (item + G < 2048) LRU_LOAD_XR(item + G);
        }
        __syncthreads();
        if (PROBE_SEL >= 0) pt1 = __builtin_amdgcn_s_memrealtime();
#pragma unroll
        for (int rt = 0; rt < 2; ++rt) {
            f32x16 acc;
#pragma unroll
            for (int i = 0; i < 16; ++i) acc[i] = 0.f;
#pragma unroll
            for (int ks = 0; ks < 8; ++ks) { const bf16x8 af = *(const LAS bf16x8*)(XCb + (32 * rt + r) * 272 + (16 * ks + 8 * h) * 2); acc = MFMA32(af, bfr[ks], acc); }
#pragma unroll
            for (int k = 0; k < 8; ++k) {
                const float g0 = sigmoidf_(acc[2 * k] + bias), g1 = sigmoidf_(acc[2 * k + 1] + bias);
                const float o0 = __shfl_xor(g0, 16), o1 = __shfl_xor(g1, 16);
                const float mine = isI ? g1 : g0, oth = isI ? o1 : o0;
                const float rg = isI ? oth : mine, ig = isI ? mine : oth;
                const int tl = 32 * rt + ((2 * k) & 3) + 8 * ((2 * k) >> 2) + 4 * h + (isI ? 1 : 0);
                const float la = -sp8 * rg;
                const float xv1 = XCF[tl * 128 + cl];
                AA[tl * 128 + cl] = fexp(la);
                XCF[tl * 128 + cl] = __builtin_amdgcn_sqrtf(one_minus_exp(2.0f * la)) * (ig * xv1); }
        }
        __syncthreads();
        if (PROBE_SEL >= 0) pt2 = __builtin_amdgcn_s_memrealtime();
        if (wave < 4) {
            const int cs = 32 * wave + (lane & 31), sg = lane >> 5; const int tb = 32 * sg;
            float A = 1.f, H = 0.f;
#pragma unroll 8
            for (int s2 = 0; s2 < 32; ++s2) { const float av = AA[(tb + s2) * 128 + cs], uv = XCF[(tb + s2) * 128 + cs]; H = av * H + uv; A *= av; }
            const float A0 = __shfl(A, lane & 31), H0 = __shfl(H, lane & 31);
            float hh = sg ? H0 : 0.f, Ac = sg ? A0 : 1.f;
            unsigned* HL = (unsigned*)(ws + WS_AR + AR_HL) + (size_t)(t0 + tb) * DM + c0 + cs;
#pragma unroll 8
            for (int s2 = 0; s2 < 32; ++s2) { const float av = AA[(tb + s2) * 128 + cs], uv = XCF[(tb + s2) * 128 + cs]; hh = av * hh + uv; Ac *= av; __builtin_nontemporal_store(pkh2(hh, Ac), HL + (size_t)s2 * DM); }
            if (sg) { ((float*)(ws + WS_AGGA))[(size_t)(b * 32 + ck) * DM + c0 + cs] = Ac; ((float*)(ws + WS_AGGH))[(size_t)(b * 32 + ck) * DM + c0 + cs] = hh; }
        }
        __syncthreads();
        if (PROBE_SEL >= 0) { pt3 = __builtin_amdgcn_s_memrealtime(); pa0 += pt1 - pt0; pa1 += pt2 - pt1; pa2 += pt3 - pt2; }
    }
    if (PROBE_SEL >= 0 && blockIdx.x == 0 && tid == 0) { unsigned long long* TSP = (unsigned long long*)(ws + WS_CTL + 512 * 1024); TSP[96] += pa0; TSP[97] += pa1; TSP[98] += pa2; }
}

DI bf16x8 pack8(const f32x16& x, int s) {
    u32x4 p; p.x = pk2(x[8 * s], x[8 * s + 1]); p.y = pk2(x[8 * s + 2], x[8 * s + 3]); p.z = pk2(x[8 * s + 4], x[8 * s + 5]); p.w = pk2(x[8 * s + 6], x[8 * s + 7]);
    return __builtin_bit_cast(bf16x8, p);
}
DI void attn_item(unsigned char* ws, LAS unsigned char* wl  , int hd, int b, int qi, int qi0  , int lane) {
    const bf16_t* Q = (const bf16_t*)(ws + WS_AR + AR_Q); const bf16_t* Kp = (const bf16_t*)(ws + WS_AR + AR_K); const bf16_t* V = (const bf16_t*)(ws + WS_AR + AR_V);
    bf16_t* OG = (bf16_t*)(ws + WS_AR + AR_OG); float* LSE = (float*)(ws + WS_LSE);
    const int sh = 2 * (hd >> 2), tps = 64 >> sh;
    const int rstream = qi / tps, m0 = 32 * (qi % tps);
    const int r = lane & 31, h = lane >> 5;
    const int lrow = lane >> 4, lch = lane & 15;
    LAS unsigned char* KL = wl; LAS unsigned char* VL = wl + 8704;
    const size_t qtok = (size_t)b * SEQ + ((size_t)(m0 + r) << sh) + rstream;
    const int kt0 = (m0 >= 128) ? 0 : (4 - (m0 >> 5));
    const size_t tstride = ((size_t)32 << sh) * AW, rstride = ((size_t)4 << sh) * AW;
    const size_t stok0 = (size_t)b * SEQ + ((size_t)(m0 - 128 + 32 * kt0 + lrow) << sh) + rstream;
    const bf16_t* kg = Kp + stok0 * AW + hd * 128 + 8 * lch; const bf16_t* vg = V + stok0 * AW + hd * 128 + 8 * lch;
    u32x4 ks_[8], vs_[8];
#pragma unroll
    for (int i = 0; i < 8; ++i) ks_[i] = *(const u32x4*)(kg + (size_t)i * rstride);
#pragma unroll
    for (int i = 0; i < 8; ++i) vs_[i] = *(const u32x4*)(vg + (size_t)i * rstride);
    const bf16_t* qrow = Q + qtok * AW + hd * 128 + 8 * h;
    bf16x8 qf[8];
#pragma unroll
    for (int ks = 0; ks < 8; ++ks) qf[ks] = *(const bf16x8*)(qrow + 16 * ks);
    bf16x8 idf[2];
#pragma unroll
    for (int e = 0; e < 2; ++e)
#pragma unroll
        for (int j = 0; j < 8; ++j) idf[e][j] = (16 * e + 8 * h + j == r) ? (short)0x3F80 : (short)0;
    f32x16 O[4];
#pragma unroll
    for (int dt = 0; dt < 4; ++dt)
#pragma unroll
        for (int i = 0; i < 16; ++i) O[dt][i] = 0.f;
    float mrun = -1e30f, lpart = 0.f;
    constexpr float L2E = 1.4426950408889634f;
    const int woff = lrow * 272 + lch * 16, roff = r * 272 + h * 16;
    const int trb = (4 * h + ((lane & 15) >> 2)) * 272 + (16 * (r >> 4) + 4 * (lane & 3)) * 2;
    const int dq = 0, nsteps = 5; (void)qi0;
    for (int st = 0; st < nsteps; ++st) {
        const int kt = st + dq;
        if (kt >= kt0 && kt < 5) {
#pragma unroll
        for (int i = 0; i < 8; ++i) { *(LAS u32x4*)(KL + woff + i * 1088) = ks_[i]; *(LAS u32x4*)(VL + woff + i * 1088) = vs_[i]; }
        if (kt < 4) { kg += tstride; vg += tstride;
#pragma unroll
            for (int i = 0; i < 8; ++i) ks_[i] = *(const u32x4*)(kg + (size_t)i * rstride);
#pragma unroll
            for (int i = 0; i < 8; ++i) vs_[i] = *(const u32x4*)(vg + (size_t)i * rstride); }
        f32x16 Sx;
#pragma unroll
        for (int i = 0; i < 16; ++i) Sx[i] = 0.f;
        __builtin_amdgcn_s_setprio(1);
#pragma unroll
        for (int ks = 0; ks < 8; ++ks) { const bf16x8 kf = *(const LAS bf16x8*)(KL + roff + 32 * ks); Sx = MFMA32(kf, qf[ks], Sx); }
        __builtin_amdgcn_s_setprio(0);
        float mx = -1e30f;
        if (kt == 0 || kt == 4) {
#pragma unroll
            for (int i = 0; i < 16; ++i) { const int ki = (i & 3) + 8 * (i >> 2) + 4 * h;
                if ((kt == 0 && ki < r) || (kt == 4 && ki > r)) Sx[i] = -1e30f; } }
#pragma unroll
        for (int i = 0; i < 16; ++i) mx = fmaxf(mx, Sx[i]);
        mx = fmaxf(mx, __shfl_xor(mx, 32));
        const float mnew = fmaxf(mrun, mx), alpha = __builtin_amdgcn_exp2f((mrun - mnew) * L2E);
        float ps = 0.f;
#pragma unroll
        for (int i = 0; i < 16; ++i) { Sx[i] = __builtin_amdgcn_exp2f((Sx[i] - mnew) * L2E); ps += Sx[i]; }
        const bool any_grow = __builtin_amdgcn_ballot_w64(mnew > mrun) != 0ull;
        lpart = lpart * alpha + ps; mrun = mnew;
        const bf16x8 pf0 = pack8(Sx, 0), pf1 = pack8(Sx, 1);
#pragma unroll
        for (int dt = 0; dt < 4; ++dt) {
            const LAS unsigned char* tb = VL + trb + 64 * dt;
            const s16x4 a00 = __builtin_amdgcn_ds_read_tr16_b64_v4i16((LAS s16x4*)(tb)), a01 = __builtin_amdgcn_ds_read_tr16_b64_v4i16((LAS s16x4*)(tb + 8 * 272));
            const s16x4 a10 = __builtin_amdgcn_ds_read_tr16_b64_v4i16((LAS s16x4*)(tb + 16 * 272)), a11 = __builtin_amdgcn_ds_read_tr16_b64_v4i16((LAS s16x4*)(tb + 24 * 272));
            const bf16x8 xf0 = __builtin_shufflevector(a00, a01, 0, 1, 2, 3, 4, 5, 6, 7), xf1 = __builtin_shufflevector(a10, a11, 0, 1, 2, 3, 4, 5, 6, 7);
            if (any_grow) {
#pragma unroll
            for (int i = 0; i < 16; ++i) O[dt][i] *= alpha; }
            __builtin_amdgcn_s_setprio(1); O[dt] = MFMA32(xf0, pf0, O[dt]); O[dt] = MFMA32(xf1, pf1, O[dt]); __builtin_amdgcn_s_setprio(0);
        }
        }
        __builtin_amdgcn_s_barrier();
    }
    const float ltot = lpart + __shfl_xor(lpart, 32), inv = frcp(ltot);
    bf16_t* orow = OG + qtok * AW + hd * 128 + 4 * h;
#pragma unroll
    for (int dt = 0; dt < 4; ++dt)
#pragma unroll
        for (int gq = 0; gq < 4; ++gq) { u32x2 w; w.x = pk2(O[dt][4 * gq] * inv, O[dt][4 * gq + 1] * inv); w.y = pk2(O[dt][4 * gq + 2] * inv, O[dt][4 * gq + 3] * inv);
            *(u32x2*)(orow + 32 * dt + 8 * gq) = w; }
    if (h == 0) LSE[qtok * 12 + hd] = mrun + logf(ltot);
}

DI void b2_fix(CArgsP a, int tid) {
    unsigned char* ws = wsG(a);
    const float* AGA = (const float*)(ws + WS_AGGA); const float* AGH = (const float*)(ws + WS_AGGH);
    const unsigned* HL = (const unsigned*)(ws + WS_AR + AR_HL); const bf16_t* GG = (const bf16_t*)(ws + WS_AR + AR_GG); bf16_t* YR = (bf16_t*)(ws + WS_AR + AR_YR);
    for (int it = blockIdx.x; it < 256; it += gridDim.x) {
        const int b = it >> 5, ck = it & 31, c = 4 * (tid & 255), th = tid >> 8;
        f32x4 carry = {0.f, 0.f, 0.f, 0.f};
        {
            const float* pa = AGA + (size_t)(b * 32) * DM + c; const float* ph = AGH + (size_t)(b * 32) * DM + c;
            int j = 0;
            for (; j + 8 <= ck; j += 8) { f32x4 A[8], H[8];
#pragma unroll
                for (int e = 0; e < 8; ++e) { A[e] = *(const f32x4*)(pa + (size_t)(j + e) * DM); H[e] = *(const f32x4*)(ph + (size_t)(j + e) * DM); }
#pragma unroll
                for (int e = 0; e < 8; ++e) carry = A[e] * carry + H[e]; }
            for (; j < ck; ++j) { const f32x4 A = *(const f32x4*)(pa + (size_t)j * DM), H = *(const f32x4*)(ph + (size_t)j * DM); carry = A * carry + H; }
        }
        const size_t tb = (size_t)b * SEQ + ck * 64 + 32 * th;
#pragma unroll 4
        for (int s = 0; s < 32; ++s) { const size_t off = (tb + s) * DM + c;
            const u32x4 hl = __builtin_nontemporal_load((const u32x4*)(HL + off)); const u32x2 gg = __builtin_nontemporal_load((const u32x2*)(GG + off));
            const float y0 = (hlo(hl.x) + hhi(hl.x) * carry[0]) * bflo(gg.x), y1 = (hlo(hl.y) + hhi(hl.y) * carry[1]) * bfhi(gg.x);
            const float y2 = (hlo(hl.z) + hhi(hl.z) * carry[2]) * bflo(gg.y), y3 = (hlo(hl.w) + hhi(hl.w) * carry[3]) * bfhi(gg.y);
            u32x2 w; w.x = pk2(y0, y1); w.y = pk2(y2, y3); *(u32x2*)(YR + off) = w; }
    }
}
DI void b2_merge(unsigned char* ws, int gtid, int nthr) {
    const bf16_t* OG = (const bf16_t*)(ws + WS_AR + AR_OG); const float* LSE = (const float*)(ws + WS_LSE); bf16_t* YA = (bf16_t*)(ws + WS_AR + AR_YA);
    for (int i = gtid; i < T * 64; i += nthr) {
        const int t = i >> 6, j = (i >> 4) & 3, d8 = i & 15;
        const float l0 = LSE[(size_t)t * 12 + j], l1 = LSE[(size_t)t * 12 + 4 + j], l2 = LSE[(size_t)t * 12 + 8 + j];
        const float mx = fmaxf(l0, fmaxf(l1, l2)); const float e0 = fexp(l0 - mx), e1 = fexp(l1 - mx), e2 = fexp(l2 - mx); const float inv = frcp(e0 + e1 + e2);
        const float w0 = e0 * inv, w1 = e1 * inv, w2 = e2 * inv;
        const bf16_t* op = OG + (size_t)t * AW + j * 128 + 8 * d8;
        const u32x4 o0 = __builtin_nontemporal_load((const u32x4*)op), o1 = __builtin_nontemporal_load((const u32x4*)(op + 512)), o2 = __builtin_nontemporal_load((const u32x4*)(op + 1024));
        u32x4 w;
        w.x = pk2(w0 * bflo(o0.x) + w1 * bflo(o1.x) + w2 * bflo(o2.x), w0 * bfhi(o0.x) + w1 * bfhi(o1.x) + w2 * bfhi(o2.x));
        w.y = pk2(w0 * bflo(o0.y) + w1 * bflo(o1.y) + w2 * bflo(o2.y), w0 * bfhi(o0.y) + w1 * bfhi(o1.y) + w2 * bfhi(o2.y));
        w.z = pk2(w0 * bflo(o0.z) + w1 * bflo(o1.z) + w2 * bflo(o2.z), w0 * bfhi(o0.z) + w1 * bfhi(o1.z) + w2 * bfhi(o2.z));
        w.w = pk2(w0 * bflo(o0.w) + w1 * bflo(o1.w) + w2 * bflo(o2.w), w0 * bfhi(o0.w) + w1 * bfhi(o1.w) + w2 * bfhi(o2.w));
        *(u32x4*)(YA + (size_t)t * 512 + j * 128 + 8 * d8) = w;
    }
}

DI void e2_convact(CArgsP a, int l, int gtid, int nthr) {
    unsigned char* ws = wsG(a);
    const bf16_t* U = (const bf16_t*)(ws + WS_AR + AR_U); bf16_t* ACT = (bf16_t*)(ws + WS_AR + AR_ACT);
    const float* cw = inF(a, 18) + (size_t)l * 3 * NUP; const float* cb = inF(a, 19) + (size_t)l * NUP;
    for (int i = gtid; i < 1024 * 384; i += nthr) {
        const int c8 = i % 384, run = i / 384, c = 8 * c8; const int tstart = run * 16, p0 = tstart & (SEQ - 1);
        float wg[3][8], wv[3][8], bg[8], bv[8];
#pragma unroll
        for (int k = 0; k < 3; ++k) { const f32x4 g0 = *(const f32x4*)(cw + k * NUP + c), g1 = *(const f32x4*)(cw + k * NUP + c + 4), v0 = *(const f32x4*)(cw + k * NUP + DFF + c), v1 = *(const f32x4*)(cw + k * NUP + DFF + c + 4);
#pragma unroll
            for (int e = 0; e < 4; ++e) { wg[k][e] = g0[e]; wg[k][4 + e] = g1[e]; wv[k][e] = v0[e]; wv[k][4 + e] = v1[e]; } }
        { const f32x4 g0 = *(const f32x4*)(cb + c), g1 = *(const f32x4*)(cb + c + 4), v0 = *(const f32x4*)(cb + DFF + c), v1 = *(const f32x4*)(cb + DFF + c + 4);
#pragma unroll
          for (int e = 0; e < 4; ++e) { bg[e] = g0[e]; bg[4 + e] = g1[e]; bv[e] = v0[e]; bv[4 + e] = v1[e]; } }
        float g2[8], g1r[8], v2[8], v1r[8];
#pragma unroll
        for (int e = 0; e < 8; ++e) { g2[e] = 0.f; g1r[e] = 0.f; v2[e] = 0.f; v1r[e] = 0.f; }
        if (p0 >= 2) {
            const u32x4 ga = *(const u32x4*)(U + (size_t)(tstart - 2) * NUP + c), gb = *(const u32x4*)(U + (size_t)(tstart - 1) * NUP + c);
            const u32x4 va = *(const u32x4*)(U + (size_t)(tstart - 2) * NUP + DFF + c), vb = *(const u32x4*)(U + (size_t)(tstart - 1) * NUP + DFF + c);
            g2[0] = bflo(ga.x); g2[1] = bfhi(ga.x); g2[2] = bflo(ga.y); g2[3] = bfhi(ga.y); g2[4] = bflo(ga.z); g2[5] = bfhi(ga.z); g2[6] = bflo(ga.w); g2[7] = bfhi(ga.w);
            g1r[0] = bflo(gb.x); g1r[1] = bfhi(gb.x); g1r[2] = bflo(gb.y); g1r[3] = bfhi(gb.y); g1r[4] = bflo(gb.z); g1r[5] = bfhi(gb.z); g1r[6] = bflo(gb.w); g1r[7] = bfhi(gb.w);
            v2[0] = bflo(va.x); v2[1] = bfhi(va.x); v2[2] = bflo(va.y); v2[3] = bfhi(va.y); v2[4] = bflo(va.z); v2[5] = bfhi(va.z); v2[6] = bflo(va.w); v2[7] = bfhi(va.w);
            v1r[0] = bflo(vb.x); v1r[1] = bfhi(vb.x); v1r[2] = bflo(vb.y); v1r[3] = bfhi(vb.y); v1r[4] = bflo(vb.z); v1r[5] = bfhi(vb.z); v1r[6] = bflo(vb.w); v1r[7] = bfhi(vb.w);
        }
#pragma unroll 4
        for (int s = 0; s < 16; ++s) {
            const u32x4 gc = __builtin_nontemporal_load((const u32x4*)(U + (size_t)(tstart + s) * NUP + c)), vc = __builtin_nontemporal_load((const u32x4*)(U + (size_t)(tstart + s) * NUP + DFF + c));
            float g0[8], v0[8];
            g0[0] = bflo(gc.x); g0[1] = bfhi(gc.x); g0[2] = bflo(gc.y); g0[3] = bfhi(gc.y); g0[4] = bflo(gc.z); g0[5] = bfhi(gc.z); g0[6] = bflo(gc.w); g0[7] = bfhi(gc.w);
            v0[0] = bflo(vc.x); v0[1] = bfhi(vc.x); v0[2] = bflo(vc.y); v0[3] = bfhi(vc.y); v0[4] = bflo(vc.z); v0[5] = bfhi(vc.z); v0[6] = bflo(vc.w); v0[7] = bfhi(vc.w);
            float o[8];
#pragma unroll
            for (int e = 0; e < 8; ++e) { const float ug = bg[e] + wg[0][e] * g2[e] + wg[1][e] * g1r[e] + wg[2][e] * g0[e]; const float uv = bv[e] + wv[0][e] * v2[e] + wv[1][e] * v1r[e] + wv[2][e] * v0[e];
                o[e] = gelu_tanh(ug) * uv; g2[e] = g1r[e]; g1r[e] = g0[e]; v2[e] = v1r[e]; v1r[e] = v0[e]; }
            u32x4 w; w.x = pk2(o[0], o[1]); w.y = pk2(o[2], o[3]); w.z = pk2(o[4], o[5]); w.w = pk2(o[6], o[7]);
            *(u32x4*)(ACT + (size_t)(tstart + s) * DFF + c) = w;
        }
    }
}

constexpr int NPHASE = 1 + 8 * DEPTH;
__global__ void __launch_bounds__(512, 2) mega(Args a_byval) {
    CArgsP a0 = (CArgsP)__builtin_amdgcn_kernarg_segment_ptr(); CArgsP a = a0;
    extern __shared__ __attribute__((aligned(16))) unsigned char lds_raw[];
    LAS unsigned char* lds = (LAS unsigned char*)lds_raw;
    unsigned char* ws0 = wsG(a);
    volatile LAS unsigned* MISC = (volatile LAS unsigned*)(lds + MISC_OFF);
    if (threadIdx.x < 64) MISC[threadIdx.x] = 0u;
    __syncthreads();
    XcdBarrier bar; bar.bar = (unsigned*)(ws0 + WS_CTL); bar.x = 0; bar.st = MISC + 8;
    if (a->coop && !USE_CG_SYNC) bar = xcd_barrier_post((unsigned*)(ws0 + WS_CTL), MISC + 8);

    unsigned long long* TS = (unsigned long long*)(ws0 + WS_CTL + 512 * 1024);
    if (PROBE_SEL >= 0 && blockIdx.x == 0 && threadIdx.x == 0) TS[0] = __builtin_amdgcn_s_memrealtime();
    for (int ph = a->ph_lo; ph < a->ph_hi; ++ph) {
        a = a0; asm volatile("" : "+s"(a));
        GAS1 unsigned char* wsg = (GAS1 unsigned char*)a->ws; asm volatile("" : "+s"(wsg)); unsigned char* ws = (unsigned char*)wsg;
        int bid = blockIdx.x; asm volatile("" : "+s"(bid));
        int G = gridDim.x; asm volatile("" : "+s"(G));
        const int NGW = G * 8, nthr = G * 512;
        int tid = threadIdx.x; asm volatile("" : "+v"(tid));
        const int lane = tid & 63, wave = __builtin_amdgcn_readfirstlane(tid >> 6);
        const int gw = bid * 8 + wave, gtid = bid * 512 + tid;
        if (ph == 0) {
          if (PHASE_MASK & 1) {
            convert_weights(a, 0, (G == 256) ? 7 : 15, lds, gw, NGW, wave, lane);
            p0_rows(a, gw, NGW, lane);
            p0_rope(a, gtid, nthr);
          }
        } else {
            const int l = (ph - 1) >> 3, sub = (ph - 1) & 7;
            float* xout = outF(a);
            bf16_t* XB = (bf16_t*)(ws + WS_XB); float* ssp = (float*)(ws + WS_SSP);
            if (sub == 0 && (PHASE_MASK & 2)) {
                pg8::Gemm g{XB, (const bf16_t*)(ws + WS_W1T), T, NIN, DM}; pg8::StaticOrder S; S.init(T, NIN, G, bid);
                pg8::EpiIn E{ssp, (bf16_t*)(ws + WS_AR + AR_XR), (bf16_t*)(ws + WS_AR + AR_GG), (bf16_t*)(ws + WS_AR + AR_SGR), (bf16_t*)(ws + WS_AR + AR_SGA),
                             (bf16_t*)(ws + WS_AR + AR_Q), (bf16_t*)(ws + WS_AR + AR_K), (bf16_t*)(ws + WS_AR + AR_V),
                             inF(a, 11) + (size_t)l * AW, inF(a, 12) + (size_t)l * AW, (const float*)(ws + WS_COS), (const float*)(ws + WS_SIN), (LAS float*)(lds + TAB_OFF)};
                pg8::gemm_phase(lds, g, S, E);
                if (G == 256 && bid >= 128) convert_weights(a, l, 8, lds, (bid - 128) * 8 + wave, 128 * 8, wave, lane);
            } else if (sub == 1 && (PHASE_MASK & 4)) {
                const bool attn_first = ((bid >> 3) & 1) != 0;
                if (!attn_first) lru_phase(a, l, lds, G, tid, wave, lane);
                unsigned long long tp0 = 0, tp1 = 0;
                if (PROBE_SEL >= 0) { __syncthreads(); tp0 = __builtin_amdgcn_s_memrealtime(); if (threadIdx.x == 0) { atomicMax((unsigned*)(TS + 80 + l), (unsigned)(tp0 - TS[1 + 8 * l + 1])); if (blockIdx.x == 0) TS[64 + l] = tp0; } }
                for (int u = bid; u < 768; u += G) attn_item(ws, lds + wave * 17408, u >> 6, (u >> 3) & 7, 8 * (u & 7) + wave, 8 * (u & 7), lane);
                if (attn_first) { __syncthreads(); lru_phase(a, l, lds, G, tid, wave, lane); }
                if (PROBE_SEL >= 0) { __syncthreads(); tp1 = __builtin_amdgcn_s_memrealtime(); if (threadIdx.x == 0) { atomicMax((unsigned*)(TS + 88 + l), (unsigned)(tp1 - tp0)); if (blockIdx.x == 0) TS[72 + l] = tp1; } }
            } else if (sub == 2 && (PHASE_MASK & 8)) {
                b2_fix(a, tid);
                b2_merge(ws, gtid, nthr);
                if (l + 1 < DEPTH) convert_weights(a, l + 1, 3, lds, gw, NGW, wave, lane);
                if (l >= 1) convert_weights(a, l, 4, lds, gw, NGW, wave, lane);
            } else if (sub == 3 && (PHASE_MASK & 16)) {
                { pg8::Gemm g{(const bf16_t*)(ws + WS_AR + AR_YR), (const bf16_t*)(ws + WS_PRT), T, DM, DM}; pg8::StaticOrder S; S.init(T, DM, G, bid);
                  pg8::EpiProj1 E{(const bf16_t*)(ws + WS_AR + AR_SGR), (bf16_t*)(ws + WS_AR + AR_TMP)}; pg8::gemm_phase(lds, g, S, E); }
                { pg8::Gemm g{(const bf16_t*)(ws + WS_AR + AR_YA), (const bf16_t*)(ws + WS_PAT), T, DM, 512}; pg8::StaticOrder S; S.init(T, DM, G, bid);
                  pg8::EpiProj2 E{(const bf16_t*)(ws + WS_AR + AR_SGA), (const bf16_t*)(ws + WS_AR + AR_TMP), (bf16_t*)(ws + WS_AR + AR_MG)}; pg8::gemm_phase(lds, g, S, E); }
            } else if (sub == 4 && (PHASE_MASK & 32)) {
                pg8::Gemm g{(const bf16_t*)(ws + WS_AR + AR_MG), (const bf16_t*)(ws + WS_WOT), T, DM, DM}; pg8::StaticOrder S; S.init(T, DM, G, bid);
                pg8::EpiResid E{xout, XB, ssp, 0}; pg8::gemm_phase(lds, g, S, E);
            } else if (sub == 5 && (PHASE_MASK & 64)) {
                pg8::Gemm g{XB, (const bf16_t*)(ws + WS_WUT), T, NUP, DM}; pg8::StaticOrder S; S.init(T, NUP, G, bid);
                pg8::EpiUp E{ssp, (bf16_t*)(ws + WS_AR + AR_U)}; pg8::gemm_phase(lds, g, S, E);
            } else if (sub == 6 && (PHASE_MASK & 128)) {
                e2_convact(a, l, gtid, nthr);
                if (l + 1 < DEPTH && G != 256) convert_weights(a, l + 1, 8, lds, gw, NGW, wave, lane);
            } else if (sub == 7 && (PHASE_MASK & 256)) {
                pg8::Gemm g{(const bf16_t*)(ws + WS_AR + AR_ACT), (const bf16_t*)(ws + WS_WDT), T, DM, DFF}; pg8::StaticOrder S; S.init(T, DM, G, bid);
                pg8::EpiResid E{xout, XB, ssp, (l == DEPTH - 1) ? 1 : 0}; pg8::gemm_phase(lds, g, S, E);
            }
        }
        if (ph + 1 < a->ph_hi || PROBE_SEL >= 0) {
            if (USE_CG_SYNC || a->coop == 2) { cg::this_grid().sync(); }
            else xcd_barrier(bar);
        }
        if (PROBE_SEL >= 0 && blockIdx.x == 0 && threadIdx.x == 0) TS[ph + 1] = __builtin_amdgcn_s_memrealtime();
    }
    if (PROBE_SEL >= 0) {
        xcd_barrier(bar);
        unsigned long long tot = 0;
        if (PROBE_SEL < 8) { for (int l = 0; l < DEPTH; ++l) tot += TS[2 + 8 * l + PROBE_SEL] - TS[1 + 8 * l + PROBE_SEL]; }
        else if (PROBE_SEL == 8) tot = TS[1] - TS[0];
        else if (PROBE_SEL == 10) { for (int l = 0; l < DEPTH; ++l) tot += TS[64 + l] - TS[2 + 8 * l]; }
        else if (PROBE_SEL == 11) { for (int l = 0; l < DEPTH; ++l) tot += TS[72 + l] - TS[64 + l]; }
        else if (PROBE_SEL >= 14 && PROBE_SEL <= 16) tot = TS[96 + PROBE_SEL - 14];
        else if (PROBE_SEL == 12) { for (int l = 0; l < DEPTH; ++l) tot += (unsigned)TS[80 + l]; }
        else if (PROBE_SEL == 13) { for (int l = 0; l < DEPTH; ++l) tot += (unsigned)TS[88 + l]; }
        else tot = TS[NPHASE] - TS[0];
        const float v = (float)tot * 0.001f;
        if (blockIdx.x == 0 && threadIdx.x == 0) outF(a)[0] += v;
    }
}

extern "C" void kernel_launch(void* const* d_in, const int* in_sizes, int n_in, void* d_out, int out_size, void* d_ws, size_t ws_size, hipStream_t stream) {
    static int grid = 0;
    if (grid == 0) {
        if (n_in != 21 || out_size != T * DM || ws_size < WS_END) { fprintf(stderr, "kernel_launch: unexpected shapes (n_in %d out %d ws %zu, need %zu)\n", n_in, out_size, ws_size, (size_t)WS_END); grid = -1; return; }
        int dev = 0, cus = 0, per_cu = 0;
        hipGetDevice(&dev); hipDeviceGetAttribute(&cus, hipDeviceAttributeMultiprocessorCount, dev);
        if (hipFuncSetAttribute((const void*)mega, hipFuncAttributeMaxDynamicSharedMemorySize, LDS_BYTES) != hipSuccess) { fprintf(stderr, "kernel_launch: hipFuncSetAttribute failed\n"); grid = -1; return; }
        if (hipOccupancyMaxActiveBlocksPerMultiprocessor(&per_cu, (const void*)mega, 512, LDS_BYTES) != hipSuccess || per_cu < 1) { fprintf(stderr, "kernel_launch: occupancy query says %d\n", per_cu); per_cu = 1; }
        (void)hipGetLastError();
        grid = cus * 1;
        fprintf(stderr, "kernel_launch: grid %d (cus %d, per_cu %d)\n", grid, cus, per_cu);
    }
    if (grid < 0) return;
    Args a{};
    for (int i = 0; i < 21; ++i) a.in[i] = d_in[i];
    a.out = (float*)d_out; a.ws = (unsigned char*)d_ws; a.pad = 0;
    hipMemsetAsync((char*)d_ws + WS_CTL, 0, (PROBE_SEL >= 0) ? CTL_BYTES : (size_t)65536, stream);
#if MK_MULTI
    for (int p = 0; p < DBG_NPH; ++p) { a.ph_lo = p; a.ph_hi = p + 1; a.coop = 0; hipLaunchKernelGGL(mega, dim3(grid), dim3(512), LDS_BYTES, stream, a); }
#else
    a.ph_lo = 0; a.ph_hi = NPHASE; a.coop = 1;
    void* args[] = {&a};
    hipError_t e = hipLaunchCooperativeKernel((const void*)mega, dim3(grid), dim3(512), args, LDS_BYTES, stream);
    if (e != hipSuccess) fprintf(stderr, "kernel_launch: cooperative launch failed: %s (grid %d)\n", hipGetErrorString(e), grid);
#endif
}
```
